# Optimizing an MI355X kernel written in HIP

```python
import math
import jax
import jax.numpy as jnp
from jax import lax
import numpy as np

D_MODEL = 1024
BATCH = 8
SEQ = 2048
DEPTH = 1
DEC_BATCH = 32
DEC_SEQ = 32
PAST_LEN = 4096

CHUNK = 64
HEAD_DIM = 64
N_HEADS_DN = 8
N_HEADS_SB = 8
DN_WIDTH = N_HEADS_DN * HEAD_DIM
SB_WIDTH = N_HEADS_SB * HEAD_DIM
MIX_WIDTH = DN_WIDTH + SB_WIDTH
CONV_K = 4
CONV_DIM = 3 * DN_WIDTH
D_FF = 4 * D_MODEL
PLE_DIM = 256
SB_QBLOCK = 128
SB_SCALE = HEAD_DIM ** -0.5
NORM_EPS = 1e-6
SB_OFFSET = CONV_DIM + DN_WIDTH + 2 * N_HEADS_DN
IN_SPLITS = (CONV_DIM, CONV_DIM + DN_WIDTH, CONV_DIM + DN_WIDTH + N_HEADS_DN, SB_OFFSET,
             SB_OFFSET + SB_WIDTH, SB_OFFSET + 2 * SB_WIDTH)
IN_DIM = SB_OFFSET + 3 * SB_WIDTH

kernel_name = "hybrid_deltanet_stickbreak_stream_step"


def rmsnorm(x, g):
    xf = x.astype(jnp.float32)
    xf = xf * lax.rsqrt(jnp.mean(xf * xf, axis=-1, keepdims=True) + NORM_EPS)
    return xf.astype(x.dtype) * g


def l2norm(x):
    xf = x.astype(jnp.float32)
    return xf * lax.rsqrt(jnp.sum(xf * xf, axis=-1, keepdims=True) + NORM_EPS)


def causal_conv(x, w, state):
    t = x.shape[1]
    xp = jnp.concatenate([state.astype(x.dtype), x], axis=1)
    y = xp[:, 0:t] * w[0]
    for i in range(1, CONV_K):
        y = y + xp[:, i:i + t] * w[i]
    return y, xp[:, t:]


def to_chunks(a, n, l):
    b, _, h = a.shape[:3]
    a = a.reshape((b, n, l, h) + a.shape[3:])
    return jnp.moveaxis(a, (1, 3), (0, 2))


def gated_delta_rule(q, k, v, g, beta, s0):
    b, t, h, dk = q.shape
    dv = v.shape[-1]
    l = min(CHUNK, t)
    n = t // l
    qc, kc, vc = to_chunks(q, n, l), to_chunks(k, n, l), to_chunks(v, n, l)
    gc, bc = to_chunks(g, n, l), to_chunks(beta, n, l)
    gcum = jnp.cumsum(gc, axis=-1)
    idx = jnp.arange(l)
    causal = idx[:, None] >= idx[None, :]
    strict = idx[:, None] > idx[None, :]
    decay = jnp.exp(jnp.where(causal, gcum[..., :, None] - gcum[..., None, :], -jnp.inf))
    kb = kc * bc[..., None]
    a_mat = jnp.where(strict, jnp.einsum('nbhid,nbhjd->nbhij', kb, kc) * decay, 0.0)
    rhs = jnp.concatenate([vc * bc[..., None], kb * jnp.exp(gcum)[..., None]], axis=-1)
    sol = lax.linalg.triangular_solve(a_mat + jnp.eye(l, dtype=a_mat.dtype), rhs,
                                      left_side=True, lower=True, unit_diagonal=True)
    u, w = sol[..., :dv], sol[..., dv:]
    qk = jnp.where(causal, jnp.einsum('nbhid,nbhjd->nbhij', qc, kc) * decay, 0.0)

    def step(s, xs):
        q_i, k_i, u_i, w_i, g_i, qk_i = xs
        v_new = u_i - jnp.einsum('bhld,bhde->bhle', w_i, s)
        o = (jnp.einsum('bhld,bhde->bhle', q_i * jnp.exp(g_i)[..., None], s)
             + jnp.einsum('bhij,bhje->bhie', qk_i, v_new))
        g_last = g_i[..., -1]
        s = (s * jnp.exp(g_last)[..., None, None]
             + jnp.einsum('bhld,bhle->bhde', k_i * jnp.exp(g_last[..., None] - g_i)[..., None], v_new))
        return s, o

    s_fin, o = lax.scan(step, s0, (qc, kc, u, w, gcum, qk))
    o = jnp.moveaxis(o, (0, 2), (1, 3)).reshape(b, t, h, dv)
    return o, s_fin


def stick_breaking_block(q, k, v, q_pos, k_pos):
    z = jnp.einsum('bqhd,bshd->bhqs', q, k).astype(jnp.float32) * SB_SCALE
    valid = k_pos[None, :] < q_pos[:, None]
    log_keep = jnp.where(valid, jax.nn.log_sigmoid(-z), 0.0)
    log_rest = lax.cumsum(log_keep, axis=3, reverse=True) - log_keep
    a = jnp.where(valid, jnp.exp(jax.nn.log_sigmoid(z) + log_rest), 0.0)
    return jnp.einsum('bhqs,bshd->bqhd', a.astype(v.dtype), v)


def stick_breaking(q, k, v, q_offset):
    b, t, h, d = q.shape
    qb = min(SB_QBLOCK, t)
    nb = t // qb
    k_pos = jnp.arange(k.shape[1])
    q_pos = (q_offset + jnp.arange(t)).reshape(nb, qb)
    q_blocks = jnp.moveaxis(q.reshape(b, nb, qb, h, d), 1, 0)
    o = lax.map(lambda a: stick_breaking_block(a[0], k, v, a[1], k_pos), (q_blocks, q_pos))
    return jnp.moveaxis(o, 0, 1).reshape(b, t, h, d)


def trunk_layer(x, p, conv_state, s0, k_past, v_past, g_mix, w_in, conv_w, a_log, dt_bias,
                g_out_dn, g_q_sb, g_k_sb, w_out, g_mlp, w_up, w_down, g_ple, w_ple_gate, w_ple_proj):
    b, t, _ = x.shape
    f32 = jnp.float32
    u = rmsnorm(x, g_mix)
    proj = u @ w_in
    dn_qkv, dn_z, dn_alpha, dn_beta, sb_q, sb_k, sb_v = jnp.split(proj, IN_SPLITS, axis=-1)

    c, new_conv = causal_conv(dn_qkv, conv_w, conv_state)
    c = jax.nn.silu(c)
    qa, ka, va = jnp.split(c, 3, axis=-1)
    qa = l2norm(qa.reshape(b, t, N_HEADS_DN, HEAD_DIM)) * (HEAD_DIM ** -0.5)
    ka = l2norm(ka.reshape(b, t, N_HEADS_DN, HEAD_DIM))
    va = va.reshape(b, t, N_HEADS_DN, HEAD_DIM).astype(f32)
    g = -jnp.exp(a_log.astype(f32)) * jax.nn.softplus(dn_alpha.astype(f32) + dt_bias.astype(f32))
    beta = jax.nn.sigmoid(dn_beta.astype(f32))
    o_a, s_new = gated_delta_rule(qa, ka, va, g, beta, s0.astype(f32))
    z = dn_z.reshape(b, t, N_HEADS_DN, HEAD_DIM)
    o_a = (rmsnorm(o_a.astype(x.dtype), g_out_dn) * jax.nn.silu(z)).reshape(b, t, DN_WIDTH)

    qb = rmsnorm(sb_q.reshape(b, t, N_HEADS_SB, HEAD_DIM), g_q_sb)
    kb = rmsnorm(sb_k.reshape(b, t, N_HEADS_SB, HEAD_DIM), g_k_sb)
    vb = sb_v.reshape(b, t, N_HEADS_SB, HEAD_DIM)
    k_all = jnp.concatenate([k_past.astype(kb.dtype), kb], axis=1)
    v_all = jnp.concatenate([v_past.astype(vb.dtype), vb], axis=1)
    o_b = stick_breaking(qb, k_all, v_all, k_past.shape[1]).reshape(b, t, SB_WIDTH)

    h = x + jnp.concatenate([o_a, o_b.astype(o_a.dtype)], axis=-1) @ w_out
    h = h + jnp.square(jax.nn.relu(rmsnorm(h, g_mlp) @ w_up)) @ w_down
    h = h + jax.nn.sigmoid(rmsnorm(h, g_ple) @ w_ple_gate) * (p @ w_ple_proj)
    return h, new_conv, s_new, kb, vb


def setup_inputs(seed: int = 0) -> dict:
    key = jax.random.key(seed)
    ks = jax.random.split(key, 32)
    f32 = jnp.float32

    def nrm(k, shape, scale):
        return jax.random.normal(k, shape, f32) * scale

    def gain(k, shape):
        return 1.0 + 0.05 * jax.random.normal(k, shape, f32)

    dt = jnp.exp(jax.random.uniform(ks[20], (DEPTH, N_HEADS_DN), f32, math.log(1e-3), math.log(1e-1)))
    return {
        "x_prompt": nrm(ks[0], (BATCH, SEQ, D_MODEL), 1.0),
        "x_sample": nrm(ks[1], (DEC_BATCH, DEC_SEQ, D_MODEL), 1.0),
        "cache_conv": nrm(ks[2], (DEPTH, DEC_BATCH, CONV_K - 1, CONV_DIM), 1.0),
        "state_delta": nrm(ks[3], (DEPTH, DEC_BATCH, N_HEADS_DN, HEAD_DIM, HEAD_DIM), 0.3),
        "cache_k": nrm(ks[4], (DEPTH, DEC_BATCH, PAST_LEN, N_HEADS_SB, HEAD_DIM), 1.0),
        "cache_v": nrm(ks[5], (DEPTH, DEC_BATCH, PAST_LEN, N_HEADS_SB, HEAD_DIM), 1.0),
        "p_prompt": nrm(ks[6], (DEPTH, BATCH, SEQ, PLE_DIM), 1.0),
        "p_sample": nrm(ks[7], (DEPTH, DEC_BATCH, DEC_SEQ, PLE_DIM), 1.0),
        "g_mix": gain(ks[8], (DEPTH, D_MODEL)),
        "w_in": nrm(ks[9], (DEPTH, D_MODEL, IN_DIM), D_MODEL ** -0.5),
        "conv_w": nrm(ks[10], (DEPTH, CONV_K, CONV_DIM), CONV_K ** -0.5),
        "a_log": jnp.log(jax.random.uniform(ks[11], (DEPTH, N_HEADS_DN), f32, 1.0, 16.0)),
        "dt_bias": dt + jnp.log(-jnp.expm1(-dt)),
        "g_out_dn": gain(ks[12], (DEPTH, HEAD_DIM)),
        "g_q_sb": gain(ks[13], (DEPTH, HEAD_DIM)),
        "g_k_sb": gain(ks[14], (DEPTH, HEAD_DIM)),
        "w_out": nrm(ks[15], (DEPTH, MIX_WIDTH, D_MODEL), MIX_WIDTH ** -0.5),
        "g_mlp": gain(ks[16], (DEPTH, D_MODEL)),
        "w_up": nrm(ks[17], (DEPTH, D_MODEL, D_FF), D_MODEL ** -0.5),
        "w_down": nrm(ks[18], (DEPTH, D_FF, D_MODEL), D_FF ** -0.5),
        "g_ple": gain(ks[19], (DEPTH, D_MODEL)),
        "w_ple_gate": nrm(ks[21], (DEPTH, D_MODEL, D_MODEL), D_MODEL ** -0.5),
        "w_ple_proj": nrm(ks[22], (DEPTH, PLE_DIM, D_MODEL), PLE_DIM ** -0.5),
    }


def reference(x_prompt, x_sample, cache_conv, state_delta, cache_k, cache_v, p_prompt, p_sample,
              g_mix, w_in, conv_w, a_log, dt_bias, g_out_dn, g_q_sb, g_k_sb, w_out, g_mlp, w_up,
              w_down, g_ple, w_ple_gate, w_ple_proj):
    bp = x_prompt.shape[0]
    y_prompt, y_sample = x_prompt, x_sample
    conv_p, delta_p, k_p, v_p = [], [], [], []
    conv_s, delta_s, k_s, v_s = [], [], [], []
    for i in range(DEPTH):
        wts = (g_mix[i], w_in[i], conv_w[i], a_log[i], dt_bias[i], g_out_dn[i], g_q_sb[i], g_k_sb[i],
               w_out[i], g_mlp[i], w_up[i], w_down[i], g_ple[i], w_ple_gate[i], w_ple_proj[i])
        y_prompt, c, s, k, v = trunk_layer(
            y_prompt, p_prompt[i],
            jnp.zeros((bp, CONV_K - 1, CONV_DIM), x_prompt.dtype),
            jnp.zeros((bp, N_HEADS_DN, HEAD_DIM, HEAD_DIM), jnp.float32),
            jnp.zeros((bp, 0, N_HEADS_SB, HEAD_DIM), x_prompt.dtype),
            jnp.zeros((bp, 0, N_HEADS_SB, HEAD_DIM), x_prompt.dtype),
            *wts)
        conv_p.append(c); delta_p.append(s); k_p.append(k); v_p.append(v)
        y_sample, c, s, k, v = trunk_layer(
            y_sample, p_sample[i], cache_conv[i], state_delta[i], cache_k[i], cache_v[i], *wts)
        conv_s.append(c); delta_s.append(s); k_s.append(k); v_s.append(v)
    return (y_prompt, y_sample,
            jnp.stack(conv_p), jnp.stack(delta_p), jnp.stack(k_p), jnp.stack(v_p),
            jnp.stack(conv_s), jnp.stack(delta_s), jnp.stack(k_s), jnp.stack(v_s))
```

```cpp
#include <hip/hip_runtime.h>
#include <hip/hip_cooperative_groups.h>
#include <cstdio>
#include <cstdint>
namespace cg = cooperative_groups;
__device__ __forceinline__ int mk_lane_id() { int l; asm volatile("v_mbcnt_lo_u32_b32 %0, -1, 0\n\tv_mbcnt_hi_u32_b32 %0, -1, %0" : "=v"(l)); return l; }
namespace pg8 {
#define PG8_LAS __attribute__((address_space(3)))
typedef unsigned short bf16_t;
typedef short bf16x8 __attribute__((ext_vector_type(8)));
typedef float f32x4 __attribute__((ext_vector_type(4)));
typedef unsigned u32x4 __attribute__((ext_vector_type(4)));
constexpr int BM = 256, BK = 64, HALF = 128, HTB = HALF * BK * 2  , STAGE_BYTES = 8 * HTB, NXCD = 8, WGM = 8;

__host__ __device__ __forceinline__ int lds_byte(int r, int c) { const int st = (r >> 4) * 2 + (c >> 5), rr = r & 15, cc = c & 31, ob = rr * 64 + cc * 2; return st * 1024 + (ob ^ (((ob >> 9) & 1) << 5)); }
__host__ __device__ __forceinline__ void stage_rc(int b, int& R, int& C) { const int st = b / 1024, sb = b % 1024, swz = sb ^ (((sb >> 9) & 1) << 5); R = (st >> 1) * 16 + swz / 64; C = (st & 1) * 32 + (swz % 64) / 2; }
__host__ __device__ __forceinline__ int perm32(int rho) { const int n = rho >> 4, i = rho & 15; return 8 * (i >> 2) + 4 * n + (i & 3); }

struct Unit { int pm, pn, ks; };
struct Gemm { const bf16_t* A; const bf16_t* Bt; int M, N, K, ld; };

struct StaticOrder {
    int nM, nN, nwg, G, c;
    __host__ __device__ void init(int M, int N, int G_, int c_) { nM = M / BM; nN = N / BM; nwg = nM * nN; G = G_; c = c_; }
    __host__ __device__ bool next(int i, Unit& u) const {
        const long L = (long)i * G + c; if (L >= nwg) return false;
        int wgid = (int)L; { const int q = nwg / NXCD, r = nwg % NXCD, xcd = wgid % NXCD, off = wgid / NXCD; wgid = (xcd < r ? xcd * (q + 1) : r * (q + 1) + (xcd - r) * q) + off; }
        const int nig = WGM * nN, gid = wgid / nig, fm = gid * WGM, gsz = (nM - fm) < WGM ? (nM - fm) : WGM;
        u.pm = fm + ((wgid % nig) % gsz); u.pn = (wgid % nig) / gsz; u.ks = 0; return true;
    }
    __device__ __forceinline__ void a_ready(const Unit&) const {}
    __device__ __forceinline__ void done(const Unit&) const {}
};

struct TailOrder {
    int S, G, c;
    __host__ __device__ void init(int S_, int G_, int c_) { S = S_; G = G_; c = c_; }
    __host__ __device__ bool next(int i, Unit& u) const { const int L = i * G + c; if (L >= 16 * S) return false; const int tile = L / S; u.ks = L - tile * S; u.pm = 64 + (tile >> 2); u.pn = tile & 3; return true; }
    __device__ __forceinline__ void a_ready(const Unit&) const {}
    __device__ __forceinline__ void done(const Unit&) const {}
};

typedef float f32x2_t __attribute__((ext_vector_type(2)));
typedef __bf16 bf16x2_t __attribute__((ext_vector_type(2)));
__device__ __forceinline__ unsigned cvt_pk_bf16(float lo, float hi) { unsigned r; asm volatile("v_cvt_pk_bf16_f32 %0, %1, %2" : "=v"(r) : "v"(lo), "v"(hi)); return r; }
__device__ __forceinline__ unsigned cvt_pk_bf16_safe(float lo, float hi) { f32x2_t v = {lo, hi}; bf16x2_t b = __builtin_convertvector(v, bf16x2_t); return __builtin_bit_cast(unsigned, b); }
constexpr int NT_ROWS = 17408, NP_ROWS = 16384;
__device__ __forceinline__ u32x4 pack8(const f32x4& a, const f32x4& b) { u32x4 w; w.x = cvt_pk_bf16(a[0], a[1]); w.y = cvt_pk_bf16(a[2], a[3]); w.z = cvt_pk_bf16(b[0], b[1]); w.w = cvt_pk_bf16(b[2], b[3]); return w; }
__device__ __forceinline__ float dot4(const f32x4& a) { return (a[0] * a[0] + a[1] * a[1]) + (a[2] * a[2] + a[3] * a[3]); }
__device__ __forceinline__ float row_rs(const float* SS, int row) {
    const f32x4* p = (const f32x4*)(SS + (size_t)row * 16); const f32x4 a = p[0], b = p[1], c = p[2], d = p[3];
    const float s = ((a[0] + a[1]) + (a[2] + a[3])) + ((b[0] + b[1]) + (b[2] + b[3])) + ((c[0] + c[1]) + (c[2] + c[3])) + ((d[0] + d[1]) + (d[2] + d[3]));
    return rsqrtf(s * (1.f / 1024.f) + 1e-6f); }

struct EpiProj {
    static constexpr bool PERM = true, AFTER_DRAIN = false;
    bf16_t* O; float* AB;
    __device__ __forceinline__ void operator()(const f32x4 (&acc)[2][2][4][2], const Unit& u, int wr, int wc, int fr, int fq) const {
        const int row0 = u.pm * BM + wr * 64 + fr;
        if (u.pn == 14) {
            if (wc == 0 && fq < 2) {
#pragma unroll
                for (int ai = 0; ai < 2; ++ai)
#pragma unroll
                    for (int m = 0; m < 4; ++m) { float* p = AB + (size_t)(row0 + ai * HALF + m * 16) * 16 + 8 * fq; *(f32x4*)p = acc[ai][0][m][0]; *(f32x4*)(p + 4) = acc[ai][0][m][1]; }
            }
            return;
        }
        const int col0 = u.pn * BM + wc * 32 + 8 * fq;
#pragma unroll
        for (int ai = 0; ai < 2; ++ai)
#pragma unroll
            for (int m = 0; m < 4; ++m) { bf16_t* rowp = O + (size_t)(row0 + ai * HALF + m * 16) * 3840 + col0;
#pragma unroll
                for (int bj = 0; bj < 2; ++bj) *(u32x4*)(rowp + bj * HALF) = pack8(acc[ai][bj][m][0], acc[ai][bj][m][1]); }
    }
};
struct EpiBf {
    static constexpr bool PERM = true, AFTER_DRAIN = false;
    bf16_t* O; int ldc;
    __device__ __forceinline__ void operator()(const f32x4 (&acc)[2][2][4][2], const Unit& u, int wr, int wc, int fr, int fq) const {
        const int row0 = u.pm * BM + wr * 64 + fr, col0 = u.pn * BM + wc * 32 + 8 * fq;
#pragma unroll
        for (int ai = 0; ai < 2; ++ai)
#pragma unroll
            for (int m = 0; m < 4; ++m) { bf16_t* rowp = O + (size_t)(row0 + ai * HALF + m * 16) * ldc + col0;
#pragma unroll
                for (int bj = 0; bj < 2; ++bj) *(u32x4*)(rowp + bj * HALF) = pack8(acc[ai][bj][m][0], acc[ai][bj][m][1]); }
    }
};
template <bool BF> struct EpiRes {
    static constexpr bool PERM = true, AFTER_DRAIN = false;
    const float* base0; const float* base1; bf16_t* Hb; float* SS;
    __device__ __forceinline__ void operator()(const f32x4 (&acc)[2][2][4][2], const Unit& u, int wr, int wc, int fr, int fq) const {
        const int row0 = u.pm * BM + wr * 64 + fr, col0 = u.pn * BM + wc * 32 + 8 * fq;
#pragma unroll
        for (int ai = 0; ai < 2; ++ai)
#pragma unroll
            for (int m = 0; m < 4; ++m) { const int row = row0 + ai * HALF + m * 16; float ss = 0.f;
#pragma unroll
                for (int bj = 0; bj < 2; ++bj) { bf16_t* hb = Hb + (size_t)row * 1024 + col0 + bj * HALF; f32x4 x0, x1;
                    if constexpr (BF) { const u32x4 pw = *(const u32x4*)hb;
                        x0[0] = __uint_as_float(pw.x << 16); x0[1] = __uint_as_float(pw.x & 0xffff0000u); x0[2] = __uint_as_float(pw.y << 16); x0[3] = __uint_as_float(pw.y & 0xffff0000u);
                        x1[0] = __uint_as_float(pw.z << 16); x1[1] = __uint_as_float(pw.z & 0xffff0000u); x1[2] = __uint_as_float(pw.w << 16); x1[3] = __uint_as_float(pw.w & 0xffff0000u); }
                    else { const float* rr = (row < NP_ROWS ? base0 + (size_t)row * 1024 : base1 + (size_t)(row - NP_ROWS) * 1024) + col0 + bj * HALF; x0 = *(const f32x4*)rr; x1 = *(const f32x4*)(rr + 4); }
                    const f32x4 v0 = acc[ai][bj][m][0] + x0, v1 = acc[ai][bj][m][1] + x1;
                    *(u32x4*)hb = pack8(v0, v1); ss += dot4(v0) + dot4(v1); }
                ss += __shfl_xor(ss, 16); ss += __shfl_xor(ss, 32); if (fq == 0) SS[(size_t)row * 16 + u.pn * 4 + wc] = ss; }
    }
};
struct EpiUp {
    static constexpr bool PERM = true, AFTER_DRAIN = false;
    const float* SS; bf16_t* O;
    __device__ __forceinline__ void operator()(const f32x4 (&acc)[2][2][4][2], const Unit& u, int wr, int wc, int fr, int fq) const {
        const int row0 = u.pm * BM + wr * 64 + fr, col0 = u.pn * BM + wc * 32 + 8 * fq;
#pragma unroll
        for (int ai = 0; ai < 2; ++ai)
#pragma unroll
            for (int m = 0; m < 4; ++m) { const int row = row0 + ai * HALF + m * 16; const float rs = row_rs(SS, row);
#pragma unroll
                for (int bj = 0; bj < 2; ++bj) { f32x4 v0 = acc[ai][bj][m][0] * rs, v1 = acc[ai][bj][m][1] * rs;
#pragma unroll
                    for (int e = 0; e < 4; ++e) { const float a = fmaxf(v0[e], 0.f), b = fmaxf(v1[e], 0.f); v0[e] = a * a; v1[e] = b * b; }
                    *(u32x4*)(O + (size_t)row * 4096 + col0 + bj * HALF) = pack8(v0, v1); } }
    }
};
struct EpiOut {
    static constexpr bool PERM = true, AFTER_DRAIN = false;
    const float* SS; const bf16_t* Hb; const bf16_t* PP; float* Y;
    __device__ __forceinline__ void operator()(const f32x4 (&acc)[2][2][4][2], const Unit& u, int wr, int wc, int fr, int fq) const {
        const int row0 = u.pm * BM + wr * 64 + fr, col0 = u.pn * BM + wc * 32 + 8 * fq;
#pragma unroll
        for (int ai = 0; ai < 2; ++ai)
#pragma unroll
            for (int m = 0; m < 4; ++m) { const int row = row0 + ai * HALF + m * 16; const float rs = row_rs(SS, row);
#pragma unroll
                for (int bj = 0; bj < 2; ++bj) { const size_t off = (size_t)row * 1024 + col0 + bj * HALF;
                    const u32x4 hw = *(const u32x4*)(Hb + off); const u32x4 pw = *(const u32x4*)(PP + off);
                    f32x4 h0, h1; h0[0] = __uint_as_float(hw.x << 16); h0[1] = __uint_as_float(hw.x & 0xffff0000u); h0[2] = __uint_as_float(hw.y << 16); h0[3] = __uint_as_float(hw.y & 0xffff0000u);
                    h1[0] = __uint_as_float(hw.z << 16); h1[1] = __uint_as_float(hw.z & 0xffff0000u); h1[2] = __uint_as_float(hw.w << 16); h1[3] = __uint_as_float(hw.w & 0xffff0000u);
                    f32x4 p0, p1; p0[0] = __uint_as_float(pw.x << 16); p0[1] = __uint_as_float(pw.x & 0xffff0000u); p0[2] = __uint_as_float(pw.y << 16); p0[3] = __uint_as_float(pw.y & 0xffff0000u);
                    p1[0] = __uint_as_float(pw.z << 16); p1[1] = __uint_as_float(pw.z & 0xffff0000u); p1[2] = __uint_as_float(pw.w << 16); p1[3] = __uint_as_float(pw.w & 0xffff0000u);
                    f32x4 y0, y1;
#pragma unroll
                    for (int e = 0; e < 4; ++e) { const float g0 = 1.f / (1.f + __expf(-acc[ai][bj][m][0][e] * rs)), g1 = 1.f / (1.f + __expf(-acc[ai][bj][m][1][e] * rs)); y0[e] = h0[e] + g0 * p0[e]; y1[e] = h1[e] + g1 * p1[e]; }
                    __builtin_nontemporal_store(y0, (f32x4*)(Y + off)); __builtin_nontemporal_store(y1, (f32x4*)(Y + off + 4)); } }
    }
};
struct EpiPart {
    static constexpr bool PERM = true, AFTER_DRAIN = false;
    bf16_t* P;
    __device__ __forceinline__ void operator()(const f32x4 (&acc)[2][2][4][2], const Unit& u, int wr, int wc, int fr, int fq) const {
        const int row0 = (u.pm - 64) * BM + wr * 64 + fr, col0 = u.pn * BM + wc * 32 + 8 * fq;
        bf16_t* base = P + (size_t)u.ks * 1048576;
#pragma unroll
        for (int ai = 0; ai < 2; ++ai)
#pragma unroll
            for (int m = 0; m < 4; ++m) { bf16_t* rowp = base + (size_t)(row0 + ai * HALF + m * 16) * 1024 + col0;
#pragma unroll
                for (int bj = 0; bj < 2; ++bj) *(u32x4*)(rowp + bj * HALF) = pack8(acc[ai][bj][m][0], acc[ai][bj][m][1]); }
    }
};
template <class Epi, class Sched, bool ALIGN_EPI = false, bool SP2 = false, int KT = 0, int LDT = 0>
__device__ __forceinline__ void gemm_phase(PG8_LAS unsigned char* lds, const Gemm g, const Sched& S, const Epi& E, const int wv  ) {
    int tid_ = wv * 64 + mk_lane_id(); asm volatile("" : "+v"(tid_));
    const int tid = tid_, wid = __builtin_amdgcn_readfirstlane(tid >> 6), lane = tid & 63, wr = wid >> 2, wc = wid & 3, fr = lane & 15, fq = lane >> 4;
    const int K = KT ? KT : g.K, LD = LDT ? LDT : g.ld, nt = K / BK;
    unsigned voffA[2], voffB[2];
#pragma unroll
    for (int i = 0; i < 2; ++i) { int R, C; stage_rc(tid * 16 + i * 8192, R, C); const int Rb = Epi::PERM ? ((R & ~31) + perm32(R & 31)) : R;
        voffA[i] = (unsigned)(R * LD + C) * 2u; voffB[i] = (unsigned)(Rb * LD + C) * 2u; }
    const size_t kstep = (size_t)(BK * 2);
    const size_t hstep = (size_t)HALF * LD * 2;
    const size_t tstep = 2 * hstep;
    const unsigned ldsw = (unsigned)wid * 1024u;
    const int aoff = lds_byte(wr * 64 + fr, fq * 8), boff = lds_byte(wc * 32 + fr, fq * 8);
#define PG8_SA(b, h) (((b) * 2 + (h)) * HTB)
#define PG8_SB(b, h) ((4 + (b) * 2 + (h)) * HTB)
#define PG8_STAGE(bufoff, gbase, voff) do { _Pragma("unroll") for (int _i = 0; _i < 2; ++_i) \
        __builtin_amdgcn_global_load_lds((const unsigned*)((const char*)(gbase) + (voff)[_i]), (PG8_LAS unsigned*)(lds + (bufoff) + ldsw + _i * 8192), 16, 0, 0); } while (0)
#define PG8_LDA(dst, b, h) do { _Pragma("unroll") for (int m = 0; m < 4; ++m) _Pragma("unroll") for (int k = 0; k < 2; ++k) dst[m][k] = *(const PG8_LAS bf16x8*)(lds + PG8_SA(b, h) + aoff + m * 2048 + k * 1024); } while (0)
#define PG8_LDB(dst, b, h) do { _Pragma("unroll") for (int n = 0; n < 2; ++n) _Pragma("unroll") for (int k = 0; k < 2; ++k) dst[n][k] = *(const PG8_LAS bf16x8*)(lds + PG8_SB(b, h) + boff + n * 2048 + k * 1024); } while (0)
#define PG8_MMA(ai, bj, At, Bt) do { __builtin_amdgcn_s_setprio(1); _Pragma("unroll") for (int m = 0; m < 4; ++m) _Pragma("unroll") for (int n = 0; n < 2; ++n) _Pragma("unroll") for (int k = 0; k < 2; ++k) \
        acc[ai][bj][m][n] = __builtin_amdgcn_mfma_f32_16x16x32_bf16(Bt[n][k], At[m][k], acc[ai][bj][m][n], 0, 0, 0); __builtin_amdgcn_s_setprio(0); } while (0)
#define PG8_WAIT_V(n) asm volatile("s_waitcnt vmcnt(" #n ")" ::: "memory")
#define PG8_WAIT_L(n) asm volatile("s_waitcnt lgkmcnt(" #n ")" ::: "memory")
#define PG8_BAR __builtin_amdgcn_s_barrier()
#define PG8_SCHED __builtin_amdgcn_sched_barrier(0)
    Unit cur, nxt; int ui = 0;
    if (!S.next(0, cur)) return;
    f32x4 acc[2][2][4][2];
#pragma unroll
    for (int a = 0; a < 2; ++a)
#pragma unroll
        for (int b = 0; b < 2; ++b)
#pragma unroll
            for (int m = 0; m < 4; ++m)
#pragma unroll
                for (int n = 0; n < 2; ++n) acc[a][b][m][n] = (f32x4){0.f, 0.f, 0.f, 0.f};
    bf16x8 At[4][2], B0[2][2], B1[2][2];
    const char* cA = (const char*)g.A + (size_t)cur.pm * tstep + (size_t)cur.ks * K * 2; const char* cB = (const char*)g.Bt + (size_t)cur.pn * tstep + (size_t)cur.ks * K * 2;
    S.a_ready(cur);
    if constexpr (SP2) {
        PG8_STAGE(PG8_SB(0, 0), cB, voffB); PG8_STAGE(PG8_SB(0, 1), cB + hstep, voffB); PG8_STAGE(PG8_SA(0, 0), cA, voffA); PG8_STAGE(PG8_SA(0, 1), cA + hstep, voffA);
        if (wr == 1) PG8_BAR;
        PG8_WAIT_V(2); PG8_BAR;
        PG8_STAGE(PG8_SB(1, 0), cB + kstep, voffB); PG8_STAGE(PG8_SA(1, 0), cA + kstep, voffA); PG8_STAGE(PG8_SB(1, 1), cB + hstep + kstep, voffB);
        PG8_WAIT_V(6); PG8_BAR;
    } else {
        PG8_STAGE(PG8_SB(0, 0), cB, voffB); PG8_STAGE(PG8_SA(0, 0), cA, voffA); PG8_STAGE(PG8_SB(0, 1), cB + hstep, voffB); PG8_STAGE(PG8_SA(0, 1), cA + hstep, voffA);
        if (wr == 1) PG8_BAR;
        PG8_WAIT_V(4); PG8_BAR;
        PG8_STAGE(PG8_SB(1, 0), cB + kstep, voffB); PG8_STAGE(PG8_SA(1, 0), cA + kstep, voffA); PG8_STAGE(PG8_SB(1, 1), cB + hstep + kstep, voffB);
        PG8_WAIT_V(6); PG8_BAR;
    }
    for (;;) {
        const bool has_next = S.next(ui + 1, nxt);
        const char* nA = has_next ? (const char*)g.A + (size_t)nxt.pm * tstep + (size_t)nxt.ks * K * 2 : cA; const char* nB = has_next ? (const char*)g.Bt + (size_t)nxt.pn * tstep + (size_t)nxt.ks * K * 2 : cB;
        for (int t = 0; t < nt; t += 2) {
            const bool last = (t == nt - 2);
            const char* a1 = cA + (size_t)(t + 1) * kstep;
            const char* a2 = last ? nA : cA + (size_t)(t + 2) * kstep; const char* b2 = last ? nB : cB + (size_t)(t + 2) * kstep;
            const char* a3 = a2 + kstep; const char* b3 = b2 + kstep;
            if (last && has_next) S.a_ready(nxt);
            if constexpr (SP2) {
            PG8_LDB(B0, 0, 0); PG8_LDB(B1, 0, 1); PG8_SCHED; PG8_LDA(At, 0, 0); PG8_STAGE(PG8_SA(1, 1), a1 + hstep, voffA);
            PG8_WAIT_V(8); PG8_WAIT_L(0); PG8_BAR; PG8_MMA(0, 0, At, B0); PG8_MMA(0, 1, At, B1); PG8_BAR; PG8_SCHED;
            PG8_LDA(At, 0, 1); PG8_STAGE(PG8_SB(0, 0), b2, voffB); PG8_STAGE(PG8_SB(0, 1), b2 + hstep, voffB); PG8_STAGE(PG8_SA(0, 0), a2, voffA);
            PG8_WAIT_V(8); PG8_WAIT_L(0); PG8_BAR; PG8_MMA(1, 0, At, B0); PG8_MMA(1, 1, At, B1); PG8_BAR; PG8_SCHED;
            PG8_LDB(B0, 1, 0); PG8_LDB(B1, 1, 1); PG8_SCHED; PG8_LDA(At, 1, 0); PG8_STAGE(PG8_SA(0, 1), a2 + hstep, voffA);
            PG8_WAIT_V(8); PG8_WAIT_L(0); PG8_BAR; PG8_MMA(0, 0, At, B0); PG8_MMA(0, 1, At, B1); PG8_BAR; PG8_SCHED;
            PG8_LDA(At, 1, 1); PG8_STAGE(PG8_SB(1, 0), b3, voffB); PG8_STAGE(PG8_SB(1, 1), b3 + hstep, voffB); PG8_STAGE(PG8_SA(1, 0), a3, voffA);
            PG8_WAIT_V(8); PG8_WAIT_L(0); PG8_BAR; PG8_MMA(1, 0, At, B0); PG8_MMA(1, 1, At, B1); PG8_BAR; PG8_SCHED;
            } else {
            PG8_LDB(B0, 0, 0); PG8_SCHED; PG8_LDA(At, 0, 0); PG8_STAGE(PG8_SA(1, 1), a1 + hstep, voffA);
            PG8_WAIT_L(8); PG8_BAR; PG8_WAIT_L(0); PG8_MMA(0, 0, At, B0); PG8_BAR; PG8_SCHED;
            PG8_LDB(B1, 0, 1); PG8_STAGE(PG8_SB(0, 0), b2, voffB);
            PG8_BAR; PG8_WAIT_L(0); PG8_MMA(0, 1, At, B1); PG8_BAR;
            PG8_LDA(At, 0, 1); PG8_STAGE(PG8_SA(0, 0), a2, voffA);
            PG8_BAR; PG8_WAIT_L(0); PG8_MMA(1, 0, At, B0); PG8_BAR; PG8_SCHED;
            PG8_STAGE(PG8_SB(0, 1), b2 + hstep, voffB);
            PG8_WAIT_V(6); PG8_BAR; PG8_MMA(1, 1, At, B1); PG8_BAR;
            PG8_LDB(B0, 1, 0); PG8_SCHED; PG8_LDA(At, 1, 0); PG8_STAGE(PG8_SA(0, 1), a2 + hstep, voffA);
            PG8_WAIT_L(8); PG8_BAR; PG8_WAIT_L(0); PG8_MMA(0, 0, At, B0); PG8_BAR; PG8_SCHED;
            PG8_LDB(B1, 1, 1); PG8_STAGE(PG8_SB(1, 0), b3, voffB);
            PG8_BAR; PG8_WAIT_L(0); PG8_MMA(0, 1, At, B1); PG8_BAR;
            PG8_LDA(At, 1, 1); PG8_STAGE(PG8_SA(1, 0), a3, voffA);
            PG8_BAR; PG8_WAIT_L(0); PG8_MMA(1, 0, At, B0); PG8_BAR; PG8_SCHED;
            PG8_STAGE(PG8_SB(1, 1), b3 + hstep, voffB);
            PG8_WAIT_V(6); PG8_BAR; PG8_MMA(1, 1, At, B1); PG8_BAR;
            }
        }
        if constexpr (ALIGN_EPI) { if (wr == 0) PG8_BAR; }
        if constexpr (!Epi::AFTER_DRAIN) { E(acc, cur, wr, wc, fr, fq); S.done(cur); }
        if (!has_next) break;
#pragma unroll
        for (int a = 0; a < 2; ++a)
#pragma unroll
            for (int b = 0; b < 2; ++b)
#pragma unroll
                for (int m = 0; m < 4; ++m)
#pragma unroll
                    for (int n = 0; n < 2; ++n) acc[a][b][m][n] = (f32x4){0.f, 0.f, 0.f, 0.f};
        cur = nxt; cA = nA; cB = nB; ++ui;
        if constexpr (ALIGN_EPI) { if (wr == 1) PG8_BAR; }
    }
    PG8_WAIT_V(0);
    if constexpr (!ALIGN_EPI) { if (wr == 0) PG8_BAR; }
    PG8_BAR;
    if constexpr (Epi::AFTER_DRAIN) { E.fused(acc, cur, wr, wc, fr, fq, lds, wid, lane); S.done(cur); }
#undef PG8_SA
#undef PG8_SB
#undef PG8_STAGE
#undef PG8_LDA
#undef PG8_LDB
#undef PG8_MMA
#undef PG8_WAIT_V
#undef PG8_WAIT_L
#undef PG8_BAR
#undef PG8_SCHED
}
}
#define DI __device__ __forceinline__
#define LAS __attribute__((address_space(3)))
typedef unsigned short bf16_t;
typedef short bf16x8 __attribute__((ext_vector_type(8)));
typedef short s16x4 __attribute__((ext_vector_type(4)));
typedef float f32x4 __attribute__((ext_vector_type(4)));
typedef unsigned u32x4 __attribute__((ext_vector_type(4)));
typedef unsigned u32x2 __attribute__((ext_vector_type(2)));
constexpr int NT = 17408, NP = 16384, DM = 1024, NPROJ = 3840, FF = 4096;
constexpr int C_Z = 1536, C_SBQ = 2048, C_SBK = 2560, C_SBV = 3072;
constexpr int NITEM = 2048 + 256;
constexpr float EPS = 1e-6f;
constexpr float SB_THRESH = 40.f;
constexpr size_t O_Y = 0, O_CONVP = 17825792, O_DELTAP = 17862656, O_KP = 18124800, O_VP = 26513408, O_CONVS = 34902016, O_DELTAS = 35049472, O_KS = 36098048, O_VS = 36622336;
constexpr size_t al4k(size_t x) { return (x + 4095) & ~(size_t)4095; }
constexpr size_t WS_CTL = 0, CTL_BYTES = 65536;
constexpr size_t WS_SS1 = CTL_BYTES, WS_SS2 = al4k(WS_SS1 + (size_t)NT * 64), WS_GL = al4k(WS_SS2 + (size_t)NT * 64), WS_AB = al4k(WS_GL + (size_t)NITEM * 4);
constexpr size_t WS_WIN = al4k(WS_AB + (size_t)NT * 64), WS_WOUT = al4k(WS_WIN + (size_t)NPROJ * DM * 2), WS_WUP = al4k(WS_WOUT + (size_t)DM * DM * 2), WS_WDN = al4k(WS_WUP + (size_t)FF * DM * 2);
constexpr size_t WS_WGT = al4k(WS_WDN + (size_t)DM * FF * 2), WS_WPJ = al4k(WS_WGT + (size_t)DM * DM * 2), WS_U = al4k(WS_WPJ + (size_t)DM * 256 * 2), WS_PB = al4k(WS_U + (size_t)NT * DM * 2);
constexpr size_t WS_PROJ = al4k(WS_PB + (size_t)NT * 256 * 2), WS_PP = al4k(WS_PROJ + (size_t)NT * NPROJ * 2), WS_QN = al4k(WS_PP + (size_t)NT * DM * 2), WS_KN = al4k(WS_QN + (size_t)NT * 512 * 2);
constexpr size_t WS_DN = al4k(WS_KN + (size_t)NT * 512 * 2), WS_OA = al4k(WS_DN + (size_t)NITEM * 40960), WS_HF = al4k(WS_OA + (size_t)NT * DM * 2), WS_HB = al4k(WS_HF + (size_t)NT * DM * 4);
constexpr size_t WS_ACT = al4k(WS_HB + (size_t)NT * DM * 2), WS_PART = al4k(WS_ACT + (size_t)NT * FF * 2), WS_END = al4k(WS_PART + (size_t)16 * 1048576 * 4);
constexpr int LDS_BYTES = 147456, MISC_OFF = 143360;

#define LDS_WAIT() asm volatile("s_waitcnt lgkmcnt(0)" ::: "memory")
DI unsigned pk(float lo, float hi) { return pg8::cvt_pk_bf16_safe(lo, hi); }
DI void unpack8(const u32x4 w, float* f) {
    f[0] = __uint_as_float(w.x << 16); f[1] = __uint_as_float(w.x & 0xffff0000u); f[2] = __uint_as_float(w.y << 16); f[3] = __uint_as_float(w.y & 0xffff0000u);
    f[4] = __uint_as_float(w.z << 16); f[5] = __uint_as_float(w.z & 0xffff0000u); f[6] = __uint_as_float(w.w << 16); f[7] = __uint_as_float(w.w & 0xffff0000u); }
DI u32x4 pack8f(const float* f) { u32x4 w; w.x = pk(f[0], f[1]); w.y = pk(f[2], f[3]); w.z = pk(f[4], f[5]); w.w = pk(f[6], f[7]); return w; }
DI float wave_sum(float v) {
#pragma unroll
    for (int o = 1; o < 64; o <<= 1) v += __shfl_xor(v, o);
    return v; }
DI float quad_xor1(float v) { return __int_as_float(__builtin_amdgcn_update_dpp(0, __float_as_int(v), 0xB1, 0xF, 0xF, true)); }
DI float quad_xor2(float v) { return __int_as_float(__builtin_amdgcn_update_dpp(0, __float_as_int(v), 0x4E, 0xF, 0xF, true)); }
DI float sum8(float v) { v += quad_xor1(v); v += quad_xor2(v); v += __shfl_xor(v, 4); return v; }
DI f32x4 mfma16(bf16x8 a, bf16x8 b, f32x4 c) { return __builtin_amdgcn_mfma_f32_16x16x32_bf16(a, b, c, 0, 0, 0); }

struct Args { const float* in[23]; float* out; unsigned char* ws; int ph_lo, ph_hi, li, pad; };
DI unsigned long long karg64(int byte_off) { const __attribute__((address_space(4))) char* kp = (const __attribute__((address_space(4))) char*)__builtin_amdgcn_kernarg_segment_ptr();
    return *(const volatile __attribute__((address_space(4))) unsigned long long*)(kp + byte_off); }
DI const float* in_ptr(int i) { return (const float*)karg64(8 * i); }
DI float* out_ptr() { return (float*)karg64(184); }
DI unsigned char* ws_ptr() { return (unsigned char*)karg64(192); }

DI int win_dest_row(int n) { return n < 2048 ? n : (n < 2064 ? 3584 + (n - 2048) : n - 16); }
DI void transpose_item(const float* __restrict__ W, int K, int N, bf16_t* WT, const float* __restrict__ gk, bool winmap, LAS float* scr, int item, int lane) {
    const int nblk = (N + 63) >> 6, kb = item / nblk, nb = item - kb * nblk, k0 = 64 * kb, n0 = 64 * nb;
    const int q4 = 4 * (lane & 15), nq = n0 + q4;
#pragma unroll 4
    for (int i = 0; i < 16; ++i) { const int kk = 4 * i + (lane >> 4); f32x4 w = {0.f, 0.f, 0.f, 0.f}; if (nq < N) w = *(const f32x4*)(W + (size_t)(k0 + kk) * N + nq); if (gk) w = w * gk[k0 + kk];
        LAS float* d = scr + kk * 65 + q4; d[0] = w[0]; d[1] = w[1]; d[2] = w[2]; d[3] = w[3]; }
    LDS_WAIT();
    const int c = lane & 7;
#pragma unroll
    for (int j = 0; j < 8; ++j) { const int nl = (lane >> 3) + 8 * j, n = n0 + nl; const LAS float* s = scr + (8 * c) * 65 + nl;
        if (n < N) { u32x4 o; o.x = pk(s[0 * 65], s[1 * 65]); o.y = pk(s[2 * 65], s[3 * 65]); o.z = pk(s[4 * 65], s[5 * 65]); o.w = pk(s[6 * 65], s[7 * 65]);
            const int dr = winmap ? win_dest_row(n) : n; *(u32x4*)(WT + (size_t)dr * K + k0 + 8 * c) = o; } }
    LDS_WAIT();
}
DI void phase0(const Args& a, LAS unsigned char* lds, const int wv) {
    int tid_ = wv * 64 + mk_lane_id(); asm volatile("" : "+v"(tid_)); const int tid = tid_, lane = tid & 63, wave = tid >> 6;
    const int gw = blockIdx.x * 8 + wave, NGW = gridDim.x * 8;
    unsigned char* ws = ws_ptr();
    LAS float* scr = (LAS float*)(lds + wave * 16896);
    constexpr int I_IN = 16 * 57, I_OUT = 16 * 16, I_UP = 16 * 64, I_DN = 64 * 16, I_GT = 16 * 16, I_PJ = 4 * 16;
    for (int it = gw; it < I_IN + I_OUT + I_UP + I_DN + I_GT + I_PJ; it += NGW) {
        int r = it;
        if (r < I_IN) { transpose_item(in_ptr(9), DM, 3600, (bf16_t*)(ws + WS_WIN), nullptr, true, scr, r, lane); continue; } r -= I_IN;
        if (r < I_OUT) { transpose_item(in_ptr(16), DM, DM, (bf16_t*)(ws + WS_WOUT), nullptr, false, scr, r, lane); continue; } r -= I_OUT;
        if (r < I_UP) { transpose_item(in_ptr(18), DM, FF, (bf16_t*)(ws + WS_WUP), in_ptr(17), false, scr, r, lane); continue; } r -= I_UP;
        if (r < I_DN) { transpose_item(in_ptr(19), FF, DM, (bf16_t*)(ws + WS_WDN), nullptr, false, scr, r, lane); continue; } r -= I_DN;
        if (r < I_GT) { transpose_item(in_ptr(21), DM, DM, (bf16_t*)(ws + WS_WGT), in_ptr(20), false, scr, r, lane); continue; } r -= I_GT;
        transpose_item(in_ptr(22), 256, DM, (bf16_t*)(ws + WS_WPJ), nullptr, false, scr, r, lane);
    }
    const float* gmix = in_ptr(8); const float* const xP = in_ptr(0); const float* const xS = in_ptr(1); const float* const pP = in_ptr(6); const float* const pS = in_ptr(7);
    bf16_t* U = (bf16_t*)(ws + WS_U); bf16_t* PB = (bf16_t*)(ws + WS_PB);
    for (int rb = gw; rb < NT; rb += 4 * NGW) {
        f32x4 v[4][4], pv[4];
#pragma unroll
        for (int t = 0; t < 4; ++t) { const int r = rb + t * NGW; if (r < NT) {
            const float* xr = r < NP ? xP + (size_t)r * DM : xS + (size_t)(r - NP) * DM;
#pragma unroll
            for (int j = 0; j < 4; ++j) v[t][j] = ((const f32x4*)xr)[lane + 64 * j];
            const float* pr = r < NP ? pP + (size_t)r * 256 : pS + (size_t)(r - NP) * 256;
            pv[t] = ((const f32x4*)pr)[lane]; } }
#pragma unroll
        for (int t = 0; t < 4; ++t) { const int r = rb + t * NGW; if (r < NT) {
            float ss = 0.f;
#pragma unroll
            for (int j = 0; j < 4; ++j) ss += pg8::dot4(v[t][j]);
            const float rs = rsqrtf(wave_sum(ss) * (1.f / DM) + EPS);
#pragma unroll
            for (int j = 0; j < 4; ++j) { const f32x4 g = ((const f32x4*)gmix)[lane + 64 * j]; u32x2 o; o.x = pk(v[t][j][0] * rs * g[0], v[t][j][1] * rs * g[1]); o.y = pk(v[t][j][2] * rs * g[2], v[t][j][3] * rs * g[3]);
                *(u32x2*)(U + (size_t)r * DM + 4 * (lane + 64 * j)) = o; }
            u32x2 po; po.x = pk(pv[t][0], pv[t][1]); po.y = pk(pv[t][2], pv[t][3]);
            *(u32x2*)(PB + (size_t)r * 256 + 4 * lane) = po; } }
    }
}
#define XB_TMO      128
#define XB_XCNT(j)  (256  + 64 * (j))
#define XB_XSUB(j)  (1280 + 64 * (j))
#define XB_XGEN(j)  (2304 + 64 * (j))
#define XB_TOP      3328
#define XB_TOPGEN   3392
#define XCD_BAR_WORDS 3456
#define XB_SPIN_CAP (1u << 18)

__device__ __forceinline__ unsigned xb_ld(unsigned* p)              { return __hip_atomic_load(p, __ATOMIC_RELAXED, __HIP_MEMORY_SCOPE_AGENT); }
__device__ __forceinline__ unsigned xb_add(unsigned* p, unsigned v) { return __hip_atomic_fetch_add(p, v, __ATOMIC_RELAXED, __HIP_MEMORY_SCOPE_AGENT); }
__device__ __forceinline__ unsigned xb_xcc_id() { return (unsigned)__builtin_amdgcn_s_getreg((3 << 11) | 20) & 0xFu; }
#define XB_SPIN(cond, bar) do { unsigned _sp = 0; while (cond) { __builtin_amdgcn_s_sleep(1); \
    if ((++_sp & 255u) == 0u) { if (xb_ld(&(bar)[XB_TMO])) break; if (_sp > XB_SPIN_CAP) { atomicAdd(&(bar)[XB_TMO], 1u); break; } } } } while (0)

struct XcdBarrier {
    unsigned* bar; unsigned x; int wv;
    volatile LAS unsigned* st;
};

__device__ __forceinline__ XcdBarrier xcd_barrier_post(unsigned* bar, volatile LAS unsigned* st, int wv) {
    XcdBarrier b; b.bar = bar; b.x = xb_xcc_id(); b.st = st; b.wv = wv;
    if (wv == 0 && mk_lane_id() == 0) (void)xb_add(&bar[XB_XCNT(b.x)], 1u);
    return b;
}
__device__ __forceinline__ void xcd_barrier_complete(unsigned* bar, unsigned x, unsigned& nloc, unsigned& nx) {
    const unsigned G = gridDim.x * gridDim.y * gridDim.z;
    unsigned sum, cnt, mine, sp = 0u;
    for (;;) {
        sum = 0u; cnt = 0u; mine = 0u;
#pragma unroll
        for (unsigned j = 0; j < 16; ++j) { const unsigned c = xb_ld(&bar[XB_XCNT(j)]); sum += c; cnt += (c > 0u) ? 1u : 0u; mine = (j == x) ? c : mine; }
        if (sum == G) break;
        __builtin_amdgcn_s_sleep(1);
        if ((++sp & 255u) == 0u) { if (xb_ld(&bar[XB_TMO])) break; if (sp > XB_SPIN_CAP) { atomicAdd(&bar[XB_TMO], 1u); break; } }
    }
    nloc = mine > 0u ? mine : 1u; nx = cnt > 0u ? cnt : 1u;
}

__device__ __forceinline__ void xcd_barrier(const XcdBarrier& b) {
    asm volatile("s_waitcnt vmcnt(0)" ::: "memory");
    __syncthreads();
    if (b.wv == 0 && mk_lane_id() == 0) {
        unsigned* bar = b.bar;
        __builtin_amdgcn_s_waitcnt(0);
        unsigned nloc = b.st[0], nx = b.st[1];
        if (nloc == 0u) { xcd_barrier_complete(bar, b.x, nloc, nx); b.st[0] = nloc; b.st[1] = nx; }
        const unsigned old = xb_add(&bar[XB_XSUB(b.x)], 1u);
        const unsigned gen = old / nloc;
        if (old + 1u == (gen + 1u) * nloc) {
            __builtin_amdgcn_fence(__ATOMIC_RELEASE, "agent");
            asm volatile("s_waitcnt vmcnt(0)" ::: "memory");
            const unsigned og = xb_add(&bar[XB_TOP], 1u);
            const unsigned tg = og / nx;
            if (og + 1u == (tg + 1u) * nx) xb_add(&bar[XB_TOPGEN], 1u);
            else XB_SPIN(xb_ld(&bar[XB_TOPGEN]) == tg, bar);
            __builtin_amdgcn_fence(__ATOMIC_ACQUIRE, "agent");
            xb_add(&bar[XB_XGEN(b.x)], 1u);
            asm volatile("s_waitcnt vmcnt(0)" ::: "memory");
        } else {
            XB_SPIN(xb_ld(&bar[XB_XGEN(b.x)]) == gen, bar);
            __builtin_amdgcn_fence(__ATOMIC_ACQUIRE, "agent");
            asm volatile("s_waitcnt vmcnt(0)" ::: "memory");
        }
    }
    __syncthreads();
}
struct DnIn { u32x4 p[4]; f32x4 w; };
DI void dn_fetch(int item, int tid, const bf16_t* PROJ, const float* cconv, const float* convw, DnIn& d) {
    int b, h, n, row0, L; bool samp;
    if (item < 2048) { b = item >> 8; h = (item >> 5) & 7; n = item & 31; row0 = b * 2048 + n * 64; L = 64; samp = false; }
    else { const int sid = item - 2048; b = sid >> 3; h = sid & 7; n = 0; row0 = NP + b * 32; L = 32; samp = true; }
#pragma unroll
    for (int k = 0; k < 4; ++k) {
        const int q = tid + 512 * k; u32x4 v = {0u, 0u, 0u, 0u};
        if (q < 1608) { const int part = q / 536, rem = q - part * 536, row = rem >> 3, pc = rem & 7, xi = row - 3, col = part * 512 + h * 64 + pc * 8;
            if (xi < L) {
                if (xi >= 0 || (!samp && n > 0)) v = *(const u32x4*)(PROJ + (size_t)(row0 + xi) * NPROJ + col);
                else if (samp) { const float* cp = cconv + (size_t)(b * 3 + row) * 1536 + col; const f32x4 c0 = *(const f32x4*)cp, c1 = *(const f32x4*)(cp + 4); v = pg8::pack8(c0, c1); }
            } }
        d.p[k] = v;
    }
    d.w = (f32x4){0.f, 0.f, 0.f, 0.f};
    if (tid < 192) { const int tap = tid / 48, r = tid - tap * 48, part = r >> 4, c4 = r & 15; d.w = *(const f32x4*)(convw + (size_t)tap * 1536 + part * 512 + h * 64 + c4 * 4); }
}
DI void dn_stage(int tid, LAS unsigned char* lds, const DnIn& d) {
#pragma unroll
    for (int k = 0; k < 4; ++k) { const int q = tid + 512 * k; if (q < 1608) { const int part = q / 536, rem = q - part * 536, row = rem >> 3, pc = rem & 7;
        *(LAS u32x4*)(lds + 107008 + (part * 67 + row) * 144 + pc * 16) = d.p[k]; } }
    if (tid < 192) { const int tap = tid / 48, r = tid - tap * 48, part = r >> 4, c4 = r & 15; *(LAS f32x4*)(lds + 135952 + (tap * 192 + part * 64 + c4 * 4) * 4) = d.w; }
}
DI void dn_prep_item(const Args& a, LAS unsigned char* lds, int item, int next_item, int flags, const int wv) {
    int tid_ = wv * 64 + mk_lane_id(); asm volatile("" : "+v"(tid_)); const int tid = tid_, lane = tid & 63, wave = tid >> 6;
    unsigned char* ws = ws_ptr();
    const bf16_t* PROJ = (const bf16_t*)(ws + WS_PROJ); const float* AB = (const float*)(ws + WS_AB);
    int b, h, n, row0, L; bool samp;
    if (item < 2048) { b = item >> 8; h = (item >> 5) & 7; n = item & 31; row0 = b * 2048 + n * 64; L = 64; samp = false; }
    else { const int sid = item - 2048; b = sid >> 3; h = sid & 7; n = 0; row0 = NP + b * 32; L = 32; samp = true; }
    LAS bf16_t* sQ = (LAS bf16_t*)(lds);
    LAS bf16_t* sK = (LAS bf16_t*)(lds + 9216);
    LAS float* sA = (LAS float*)(lds + 18432);
    LAS float* sR = (LAS float*)(lds + 35840);
    LAS float* sG = (LAS float*)(lds + 69632);
    LAS bf16_t* sO = (LAS bf16_t*)(lds + 70144);
    unsigned char* dn = ws + WS_DN + (size_t)item * 40960;
    const int i = tid >> 3, cg = tid & 7;
    const float* const cconv = in_ptr(2); const float* const convw = in_ptr(10);
    float c3[3][8];
#pragma unroll
    for (int part = 0; part < 3; ++part) {
        float acc[8];
#pragma unroll
        for (int e = 0; e < 8; ++e) acc[e] = 0.f;
        if (i < L) {
#pragma unroll
            for (int tap = 0; tap < 4; ++tap) {
                float xin[8]; unpack8(*(const LAS u32x4*)(lds + 107008 + (part * 67 + i + tap) * 144 + cg * 16), xin);
                const LAS float* wp = (const LAS float*)(lds + 135952) + tap * 192 + part * 64 + cg * 8; const f32x4 w0 = *(const LAS f32x4*)wp, w1 = *(const LAS f32x4*)(wp + 4);
#pragma unroll
                for (int e = 0; e < 4; ++e) { acc[e] += xin[e] * w0[e]; acc[4 + e] += xin[4 + e] * w1[e]; }
            }
        }
#pragma unroll
        for (int e = 0; e < 8; ++e) c3[part][e] = acc[e] / (1.f + __expf(-acc[e]));
    }
    {
        float sq = 0.f, sk = 0.f;
#pragma unroll
        for (int e = 0; e < 8; ++e) { sq += c3[0][e] * c3[0][e]; sk += c3[1][e] * c3[1][e]; }
        sq = sum8(sq); sk = sum8(sk);
        const float rq = rsqrtf(sq + EPS) * 0.125f, rk = rsqrtf(sk + EPS);
#pragma unroll
        for (int e = 0; e < 8; ++e) { c3[0][e] *= rq; c3[1][e] *= rk; }
        *(LAS u32x4*)(sQ + i * 72 + cg * 8) = pack8f(c3[0]); *(LAS u32x4*)(sK + i * 72 + cg * 8) = pack8f(c3[1]);
    }
    if (wave == 0) {
        float g = 0.f, be = 0.f;
        if (lane < L) { const float al = AB[(size_t)(row0 + lane) * 16 + h], br = AB[(size_t)(row0 + lane) * 16 + 8 + h]; const float xx = al + in_ptr(12)[h];
            const float sp = fmaxf(xx, 0.f) + log1pf(expf(-fabsf(xx))); g = -expf(in_ptr(11)[h]) * sp; be = 1.f / (1.f + expf(-br)); }
        float c = g;
#pragma unroll
        for (int o = 1; o < 64; o <<= 1) { const float t = __shfl_up(c, o); if (lane >= o) c += t; }
        sG[lane] = c; sG[64 + lane] = be;
    }
    __syncthreads();
    DnIn nxt;
    if (next_item < NITEM) dn_fetch(next_item, tid, PROJ, cconv, convw, nxt);
    {
        const int mat = wave >> 2, mt = wave & 3, r16 = lane & 15, g4 = lane >> 4;
        const LAS bf16_t* X = mat ? sQ : sK; bf16x8 af[2];
#pragma unroll
        for (int ks = 0; ks < 2; ++ks) af[ks] = *(const LAS bf16x8*)(X + (16 * mt + r16) * 72 + 32 * ks + 8 * g4);
#pragma unroll
        for (int nt = 0; nt < 4; ++nt) {
            f32x4 acc = {0.f, 0.f, 0.f, 0.f};
#pragma unroll
            for (int ks = 0; ks < 2; ++ks) acc = mfma16(af[ks], *(const LAS bf16x8*)(sK + (16 * nt + r16) * 72 + 32 * ks + 8 * g4), acc);
            const int j = 16 * nt + r16; const float gj = sG[j];
#pragma unroll
            for (int r = 0; r < 4; ++r) { const int ii = 16 * mt + 4 * g4 + r; const float dec = __expf(sG[ii] - gj);
                if (mat == 0) sA[ii * 68 + (j & 3) * 16 + (j >> 2)] = (ii > j) ? sG[64 + ii] * acc[r] * dec : 0.f;
                else sO[3 * 4608 + ii * 72 + j] = (bf16_t)(pk((ii >= j) ? acc[r] * dec : 0.f, 0.f) & 0xffffu); }
        }
    }
    {
        const float gi = sG[i], bi = sG[64 + i], gl = sG[63]; const float egi = __expf(gi), ekl = __expf(gl - gi);
        float t[8];
#pragma unroll
        for (int e = 0; e < 8; ++e) { sR[i * 132 + cg * 8 + e] = c3[2][e] * bi; sR[i * 132 + 64 + cg * 8 + e] = c3[1][e] * bi * egi; t[e] = c3[0][e] * egi; }
        *(u32x4*)(dn + 2 * 8192 + i * 128 + cg * 16) = pack8f(t);
#pragma unroll
        for (int e = 0; e < 8; ++e) sO[2 * 4608 + (cg * 8 + e) * 72 + i] = (bf16_t)(pk(c3[1][e] * ekl, 0.f) & 0xffffu);
        if (tid == 0) ((float*)(ws + WS_GL))[item] = gl;
    }
    __syncthreads();
    {
        const int c = tid >> 2, p = tid & 3;
        float x[16];
#pragma unroll
        for (int jj = 0; jj < 16; ++jj) x[jj] = 0.f;
        if (!(flags & 1))
#pragma unroll
        for (int r = 0; r < 4; ++r) {
            float sd[16], rh[16];
#pragma unroll
            for (int t = 0; t < 16; ++t) { const int ii = 16 * r + t; float s = 0.f; rh[t] = sR[ii * 132 + c];
#pragma unroll
                for (int jj = 0; jj < 4 * r; ++jj) s += sA[ii * 68 + p * 16 + jj] * x[jj];
                sd[t] = s; }
#pragma unroll
            for (int t = 0; t < 16; ++t) { const int ii = 16 * r + t; float s = sd[t];
#pragma unroll
                for (int jj = 4 * r; jj <= (ii >> 2); ++jj) s += sA[ii * 68 + p * 16 + jj] * x[jj];
                s += quad_xor1(s); s += quad_xor2(s);
                const float xi = rh[t] - s, own = (p == (ii & 3)) ? 1.f : 0.f;
                x[ii >> 2] = fmaf(own, xi - x[ii >> 2], x[ii >> 2]); }
        }
        if (c < 64) {
#pragma unroll
            for (int jj = 0; jj < 16; ++jj) sO[0 * 4608 + c * 72 + 4 * jj + p] = (bf16_t)(pk(x[jj], 0.f) & 0xffffu);
        } else {
#pragma unroll
            for (int jj = 0; jj < 16; ++jj) sO[1 * 4608 + (4 * jj + p) * 72 + (c - 64)] = (bf16_t)(pk(x[jj], 0.f) & 0xffffu);
        }
    }
    __syncthreads();
    {
        const int row = tid >> 3, pc = tid & 7;
        *(u32x4*)(dn + 0 * 8192 + row * 128 + pc * 16) = *(const LAS u32x4*)((LAS unsigned char*)sO + 0 * 9216 + row * 144 + pc * 16);
        *(u32x4*)(dn + 1 * 8192 + row * 128 + pc * 16) = *(const LAS u32x4*)((LAS unsigned char*)sO + 1 * 9216 + row * 144 + pc * 16);
        *(u32x4*)(dn + 3 * 8192 + row * 128 + pc * 16) = *(const LAS u32x4*)((LAS unsigned char*)sO + 2 * 9216 + row * 144 + pc * 16);
        *(u32x4*)(dn + 4 * 8192 + row * 128 + pc * 16) = *(const LAS u32x4*)((LAS unsigned char*)sO + 3 * 9216 + row * 144 + pc * 16);
    }
    if (next_item < NITEM) dn_stage(tid, lds, nxt);
    __syncthreads();
}
DI void phase2_rows(const Args& a, const int wv) {
    int tid_ = wv * 64 + mk_lane_id(); asm volatile("" : "+v"(tid_)); const int tid = tid_, lane = tid & 63, wave = tid >> 6;
    const int gw = blockIdx.x * 8 + wave, NGW = gridDim.x * 8;
    unsigned char* ws = ws_ptr();
    const bf16_t* PROJ = (const bf16_t*)(ws + WS_PROJ); bf16_t* QN = (bf16_t*)(ws + WS_QN); bf16_t* KN = (bf16_t*)(ws + WS_KN);
    float gq[8], gk[8];
    { const f32x4 q0 = *(const f32x4*)(in_ptr(14) + (lane & 7) * 8), q1 = *(const f32x4*)(in_ptr(14) + (lane & 7) * 8 + 4), k0 = *(const f32x4*)(in_ptr(15) + (lane & 7) * 8), k1 = *(const f32x4*)(in_ptr(15) + (lane & 7) * 8 + 4);
#pragma unroll
      for (int e = 0; e < 4; ++e) { gq[e] = q0[e]; gq[4 + e] = q1[e]; gk[e] = k0[e]; gk[4 + e] = k1[e]; } }
    for (int rb = gw; rb < NT; rb += 4 * NGW) {
        u32x4 wq[4], wk[4];
#pragma unroll
        for (int t = 0; t < 4; ++t) { const int r = rb + t * NGW; if (r < NT) { const bf16_t* pr = PROJ + (size_t)r * NPROJ + lane * 8;
            wq[t] = *(const u32x4*)(pr + C_SBQ); wk[t] = *(const u32x4*)(pr + C_SBK); } }
#pragma unroll
        for (int t = 0; t < 4; ++t) { const int r = rb + t * NGW; if (r < NT) {
            float q[8], k[8];
            unpack8(wq[t], q); unpack8(wk[t], k);
            float sq = 0.f, sk = 0.f;
#pragma unroll
            for (int e = 0; e < 8; ++e) { sq += q[e] * q[e]; sk += k[e] * k[e]; }
            const float rq = rsqrtf(sum8(sq) * (1.f / 64.f) + EPS), rk = rsqrtf(sum8(sk) * (1.f / 64.f) + EPS);
#pragma unroll
            for (int e = 0; e < 8; ++e) { q[e] = q[e] * rq * gq[e]; k[e] = k[e] * rk * gk[e]; }
            *(u32x4*)(QN + (size_t)r * 512 + lane * 8) = pack8f(q); *(u32x4*)(KN + (size_t)r * 512 + lane * 8) = pack8f(k);
        } }
    }
}
DI void p3_outputs(const int wv, const int bidx, const int nblk) {
    int tid_ = wv * 64 + mk_lane_id(); asm volatile("" : "+v"(tid_)); const int tid = tid_, lane = tid & 63, wave = tid >> 6;
    const int gw = bidx * 8 + wave, NGW = nblk * 8;
    unsigned char* ws = ws_ptr();
    const bf16_t* PROJ = (const bf16_t*)(ws + WS_PROJ); const bf16_t* KN = (const bf16_t*)(ws + WS_KN);
    float* const outp = out_ptr();
    for (int rb = gw; rb < NT; rb += 4 * NGW) {
        u32x4 wk[4], wvv[4];
#pragma unroll
        for (int t = 0; t < 4; ++t) { const int r = rb + t * NGW; if (r < NT) { wk[t] = *(const u32x4*)(KN + (size_t)r * 512 + lane * 8); wvv[t] = *(const u32x4*)(PROJ + (size_t)r * NPROJ + C_SBV + lane * 8); } }
#pragma unroll
        for (int t = 0; t < 4; ++t) { const int r = rb + t * NGW; if (r < NT) {
            float k[8], v[8]; unpack8(wk[t], k); unpack8(wvv[t], v);
            float* ko = outp + (r < NP ? O_KP + (size_t)r * 512 : O_KS + (size_t)(r - NP) * 512) + lane * 8;
            float* vo = outp + (r < NP ? O_VP + (size_t)r * 512 : O_VS + (size_t)(r - NP) * 512) + lane * 8;
            __builtin_nontemporal_store((f32x4){k[0], k[1], k[2], k[3]}, (f32x4*)ko); __builtin_nontemporal_store((f32x4){k[4], k[5], k[6], k[7]}, (f32x4*)(ko + 4));
            __builtin_nontemporal_store((f32x4){v[0], v[1], v[2], v[3]}, (f32x4*)vo); __builtin_nontemporal_store((f32x4){v[4], v[5], v[6], v[7]}, (f32x4*)(vo + 4));
        } }
    }
    for (int idx = bidx * 512 + tid; idx < 40 * 3 * 192; idx += nblk * 512) {
        const int seq = idx / 576, rem = idx - seq * 576, j = rem / 192, cgp = rem - j * 192;
        const int row = seq < 8 ? seq * 2048 + 2045 + j : NP + (seq - 8) * 32 + 29 + j;
        float f[8]; unpack8(*(const u32x4*)(PROJ + (size_t)row * NPROJ + cgp * 8), f);
        float* o = outp + (seq < 8 ? O_CONVP + (size_t)(seq * 3 + j) * 1536 : O_CONVS + (size_t)((seq - 8) * 3 + j) * 1536) + cgp * 8;
        *(f32x4*)o = (f32x4){f[0], f[1], f[2], f[3]}; *(f32x4*)(o + 4) = (f32x4){f[4], f[5], f[6], f[7]};
    }
}
DI void dn_scan_chain(const Args& a, LAS unsigned char* lds, int chain, const int wv) {
    int tid_ = wv * 64 + mk_lane_id(); asm volatile("" : "+v"(tid_)); const int tid = tid_, lane = tid & 63, wave = tid >> 6, r16 = lane & 15, g4 = lane >> 4, s = wave & 3, hh = wave >> 2;
    unsigned char* ws = ws_ptr();
    int b, h, nch, item0, row0, L; bool samp;
    if (chain < 64) { b = chain >> 3; h = chain & 7; nch = 32; item0 = chain * 32; row0 = b * 2048; L = 64; samp = false; }
    else { const int sid = chain - 64; b = sid >> 3; h = sid & 7; nch = 1; item0 = 2048 + sid; row0 = NP + b * 32; L = 32; samp = true; }
    LAS unsigned char* buf0 = lds;
    LAS unsigned char* sST = lds + 92160;
    LAS unsigned char* sVn = lds + 110592;
    LAS float* sOo = (LAS float*)(lds + 119808);
    const unsigned char* dn = ws + WS_DN + (size_t)item0 * 40960;
    const float* GL = (const float*)(ws + WS_GL) + item0;
    const bf16_t* PROJ = (const bf16_t*)(ws + WS_PROJ); bf16_t* OA = (bf16_t*)(ws + WS_OA);
    const int prow = tid >> 3, ppc = tid & 7;
    float S[2][4]; const float* const sd0 = in_ptr(3);
    float* dout = out_ptr() + (samp ? O_DELTAS : O_DELTAP) + (size_t)(b * 8 + h) * 4096;
#pragma unroll
    for (int mt = 0; mt < 2; ++mt)
#pragma unroll
        for (int r = 0; r < 4; ++r) S[mt][r] = samp ? sd0[(size_t)(b * 8 + h) * 4096 + (32 * hh + 16 * mt + 4 * g4 + r) * 64 + 16 * s + r16] : 0.f;
    u32x4 pre[5];
    {
#pragma unroll
        for (int t = 0; t < 5; ++t) pre[t] = *(const u32x4*)(dn + t * 8192 + prow * 128 + ppc * 16);
#pragma unroll
        for (int t = 0; t < 5; ++t) *(LAS u32x4*)(buf0 + t * 9216 + prow * 144 + ppc * 16) = pre[t];
        if (nch > 1) {
#pragma unroll
            for (int t = 0; t < 5; ++t) pre[t] = *(const u32x4*)(dn + (size_t)40960 + t * 8192 + prow * 128 + ppc * 16);
        }
#pragma unroll
        for (int mt = 0; mt < 2; ++mt) { u32x2 w; w.x = pk(S[mt][0], S[mt][1]); w.y = pk(S[mt][2], S[mt][3]); *(LAS u32x2*)(sST + (16 * s + r16) * 144 + (32 * hh + 16 * mt + 4 * g4) * 2) = w; }
    }
    float gout[8];
    { const f32x4 g0 = *(const f32x4*)(in_ptr(13) + ppc * 8), g1 = *(const f32x4*)(in_ptr(13) + ppc * 8 + 4);
#pragma unroll
      for (int e = 0; e < 4; ++e) { gout[e] = g0[e]; gout[4 + e] = g1[e]; } }
    u32x4 zw_n = {0u, 0u, 0u, 0u};
    if (prow < L) zw_n = *(const u32x4*)(PROJ + (size_t)(row0 + prow) * NPROJ + C_Z + h * 64 + ppc * 8);
    float gl_n = GL[0];
    __syncthreads();
    for (int n = 0; n < nch; ++n) {
        const int cur = n & 1;
        LAS unsigned char* STc = sST + cur * 9216; LAS unsigned char* STn = sST + (cur ^ 1) * 9216;
        LAS unsigned char* buf = buf0 + cur * 46080;
        if (n + 1 < nch) {
#pragma unroll
            for (int t = 0; t < 5; ++t) *(LAS u32x4*)(buf0 + (cur ^ 1) * 46080 + t * 9216 + prow * 144 + ppc * 16) = pre[t];
        }
        const u32x4 zw = zw_n; const float eg = __expf(gl_n);
        if (n + 1 < nch) {
            if (prow < L) zw_n = *(const u32x4*)(PROJ + (size_t)(row0 + 64 * (n + 1) + prow) * NPROJ + C_Z + h * 64 + ppc * 8);
            gl_n = GL[n + 1];
        }
        if (n + 2 < nch) {
#pragma unroll
            for (int t = 0; t < 5; ++t) pre[t] = *(const u32x4*)(dn + (size_t)(n + 2) * 40960 + t * 8192 + prow * 128 + ppc * 16);
        }
        bf16x8 bs[2];
#pragma unroll
        for (int ks = 0; ks < 2; ++ks) bs[ks] = *(const LAS bf16x8*)(STc + (16 * s + r16) * 144 + (32 * ks + 8 * g4) * 2);
#pragma unroll
        for (int mt = 0; mt < 2; ++mt) {
            const int i0 = 32 * hh + 16 * mt; f32x4 acc = {0.f, 0.f, 0.f, 0.f};
#pragma unroll
            for (int ks = 0; ks < 2; ++ks) acc = mfma16(*(const LAS bf16x8*)(buf + 1 * 9216 + (i0 + r16) * 144 + (32 * ks + 8 * g4) * 2), bs[ks], acc);
            const u32x2 uw = *(const LAS u32x2*)(buf + 0 * 9216 + (16 * s + r16) * 144 + (i0 + 4 * g4) * 2);
            const float v0 = __uint_as_float(uw.x << 16) - acc[0], v1 = __uint_as_float(uw.x & 0xffff0000u) - acc[1], v2 = __uint_as_float(uw.y << 16) - acc[2], v3 = __uint_as_float(uw.y & 0xffff0000u) - acc[3];
            u32x2 w; w.x = pk(v0, v1); w.y = pk(v2, v3); *(LAS u32x2*)(sVn + (16 * s + r16) * 144 + (i0 + 4 * g4) * 2) = w;
        }
        __syncthreads();
        bf16x8 bv[2];
#pragma unroll
        for (int ks = 0; ks < 2; ++ks) bv[ks] = *(const LAS bf16x8*)(sVn + (16 * s + r16) * 144 + (32 * ks + 8 * g4) * 2);
#pragma unroll
        for (int mt = 0; mt < 2; ++mt) {
            const int i0 = 32 * hh + 16 * mt; f32x4 acc = {0.f, 0.f, 0.f, 0.f};
#pragma unroll
            for (int ks = 0; ks < 2; ++ks) acc = mfma16(*(const LAS bf16x8*)(buf + 2 * 9216 + (i0 + r16) * 144 + (32 * ks + 8 * g4) * 2), bs[ks], acc);
#pragma unroll
            for (int ks = 0; ks < 2; ++ks) acc = mfma16(*(const LAS bf16x8*)(buf + 4 * 9216 + (i0 + r16) * 144 + (32 * ks + 8 * g4) * 2), bv[ks], acc);
#pragma unroll
            for (int r = 0; r < 4; ++r) sOo[(i0 + 4 * g4 + r) * 65 + 16 * s + r16] = acc[r];
        }
#pragma unroll
        for (int mt = 0; mt < 2; ++mt) {
            const int a0 = 32 * hh + 16 * mt; f32x4 acc = {S[mt][0] * eg, S[mt][1] * eg, S[mt][2] * eg, S[mt][3] * eg};
#pragma unroll
            for (int ks = 0; ks < 2; ++ks) acc = mfma16(*(const LAS bf16x8*)(buf + 3 * 9216 + (a0 + r16) * 144 + (32 * ks + 8 * g4) * 2), bv[ks], acc);
#pragma unroll
            for (int r = 0; r < 4; ++r) S[mt][r] = acc[r];
            u32x2 w; w.x = pk(acc[0], acc[1]); w.y = pk(acc[2], acc[3]); *(LAS u32x2*)(STn + (16 * s + r16) * 144 + (a0 + 4 * g4) * 2) = w;
        }
        __syncthreads();
        {
            float o[8], z[8], ss = 0.f;
#pragma unroll
            for (int e = 0; e < 8; ++e) { o[e] = sOo[prow * 65 + ppc * 8 + e]; ss += o[e] * o[e]; }
            const float rs = rsqrtf(sum8(ss) * (1.f / 64.f) + EPS);
            unpack8(zw, z);
#pragma unroll
            for (int e = 0; e < 8; ++e) o[e] = o[e] * rs * gout[e] * (z[e] / (1.f + __expf(-z[e])));
            if (prow < L) *(u32x4*)(OA + (size_t)(row0 + 64 * n + prow) * DM + h * 64 + ppc * 8) = pack8f(o);
        }
    }
    __syncthreads();
#pragma unroll
    for (int mt = 0; mt < 2; ++mt)
#pragma unroll
        for (int r = 0; r < 4; ++r) dout[(32 * hh + 16 * mt + 4 * g4 + r) * 64 + 16 * s + r16] = S[mt][r];
}
DI void attn_item(const Args& a, LAS unsigned char* lds, int it, const int wv) {
    int tid_ = wv * 64 + mk_lane_id(); asm volatile("" : "+v"(tid_)); const int tid = tid_, lane = tid & 63, wave = tid >> 6, r16 = lane & 15, g4 = lane >> 4;
    unsigned char* ws = ws_ptr();
    const bf16_t* PROJ = (const bf16_t*)(ws + WS_PROJ); const bf16_t* QN = (const bf16_t*)(ws + WS_QN); const bf16_t* KN = (const bf16_t*)(ws + WS_KN); bf16_t* OA = (bf16_t*)(ws + WS_OA);
    int b, h, rowbase, nq, qpos0, kb_top; bool samp;
    if (it < 1024) { const int bh = it >> 4, qt = it & 15; b = bh >> 3; h = bh & 7; rowbase = b * 2048 + qt * 128; nq = 128; qpos0 = qt * 128; kb_top = (qpos0 >> 6) + 1; samp = false; }
    else { const int sid = it - 1024; b = sid >> 3; h = sid & 7; rowbase = NP + b * 32; nq = 32; qpos0 = 4096; kb_top = 64; samp = true; }
    LAS bf16_t* sKt = (LAS bf16_t*)(lds);
    LAS bf16_t* sVt = (LAS bf16_t*)(lds + 9216);
    LAS float* sRm = (LAS float*)(lds + 18432);
    const int qi = 16 * wave + r16; const bool wvalid = (16 * wave < nq);
    const int qrow = rowbase + (wvalid ? qi : 0), qpos = qpos0 + qi;
    bf16x8 qf[2];
#pragma unroll
    for (int ks = 0; ks < 2; ++ks) qf[ks] = *(const bf16x8*)(QN + (size_t)qrow * 512 + h * 64 + 32 * ks + 8 * g4);
    f32x4 o[4];
#pragma unroll
    for (int nt = 0; nt < 4; ++nt) o[nt] = (f32x4){0.f, 0.f, 0.f, 0.f};
    float R = 0.f; bool wdone = !wvalid;
    const int key = tid >> 3, cg = tid & 7;
    const float* const cK = in_ptr(4); const float* const cV = in_ptr(5);
#define ATT_LOADKV(KB) do { const int kp = 64 * (KB) + key; kw = (u32x4){0u, 0u, 0u, 0u}; vw = (u32x4){0u, 0u, 0u, 0u}; \
        if (!samp || kp >= 4096) { const int j = samp ? kp - 4096 : kp; \
            if (!samp || j < 32) { const int krow = samp ? NP + b * 32 + j : b * 2048 + j; \
                kw = *(const u32x4*)(KN + (size_t)krow * 512 + h * 64 + cg * 8); vw = *(const u32x4*)(PROJ + (size_t)krow * NPROJ + C_SBV + h * 64 + cg * 8); } \
        } else { const size_t off = ((size_t)(b * 4096 + kp) * 8 + h) * 64 + cg * 8; \
            const f32x4 k0 = *(const f32x4*)(cK + off), k1 = *(const f32x4*)(cK + off + 4), v0 = *(const f32x4*)(cV + off), v1 = *(const f32x4*)(cV + off + 4); \
            kw = pg8::pack8(k0, k1); vw = pg8::pack8(v0, v1); } } while (0)
    u32x4 kw, vw;
    ATT_LOADKV(kb_top);
    for (int kb = kb_top; kb >= 0; --kb) {
        {
            *(LAS u32x4*)(sKt + key * 72 + cg * 8) = kw;
            sVt[(cg * 8 + 0) * 72 + key] = (bf16_t)(vw.x & 0xffffu); sVt[(cg * 8 + 1) * 72 + key] = (bf16_t)(vw.x >> 16);
            sVt[(cg * 8 + 2) * 72 + key] = (bf16_t)(vw.y & 0xffffu); sVt[(cg * 8 + 3) * 72 + key] = (bf16_t)(vw.y >> 16);
            sVt[(cg * 8 + 4) * 72 + key] = (bf16_t)(vw.z & 0xffffu); sVt[(cg * 8 + 5) * 72 + key] = (bf16_t)(vw.z >> 16);
            sVt[(cg * 8 + 6) * 72 + key] = (bf16_t)(vw.w & 0xffffu); sVt[(cg * 8 + 7) * 72 + key] = (bf16_t)(vw.w >> 16);
        }
        if (kb > 0) ATT_LOADKV(kb - 1);
        __syncthreads();
        const bool wact = !wdone && (64 * kb < qpos0 + 16 * wave + 15);
        if (wact) {
            float zz[4][4], sp[4][4], tl[4], tot[4], aft[4];
#pragma unroll
            for (int mt = 0; mt < 4; ++mt) {
                f32x4 acc = {0.f, 0.f, 0.f, 0.f};
#pragma unroll
                for (int ks = 0; ks < 2; ++ks) acc = mfma16(*(const LAS bf16x8*)(sKt + (16 * mt + r16) * 72 + 32 * ks + 8 * g4), qf[ks], acc);
                tl[mt] = 0.f;
#pragma unroll
                for (int r = 0; r < 4; ++r) { const float z = acc[r] * (0.125f * 1.44269504f); const bool valid = (64 * kb + 16 * mt + 4 * g4 + r) < qpos;
                    const float spv = (z > 60.f) ? z : __builtin_amdgcn_logf(1.f + __builtin_amdgcn_exp2f(z));
                    zz[mt][r] = z; sp[mt][r] = valid ? spv : 0.f; tl[mt] += sp[mt][r]; }
                const float v1 = __shfl_xor(tl[mt], 16), v2 = __shfl_xor(tl[mt], 32), v3 = __shfl_xor(tl[mt], 48);
                tot[mt] = tl[mt] + v1 + v2 + v3;
                aft[mt] = ((g4 ^ 1) > g4 ? v1 : 0.f) + ((g4 ^ 2) > g4 ? v2 : 0.f) + ((g4 ^ 3) > g4 ? v3 : 0.f);
            }
            float pa[4][4];
            float later = 0.f;
#pragma unroll
            for (int mt = 3; mt >= 0; --mt) {
                float c = R + later + aft[mt];
#pragma unroll
                for (int r = 3; r >= 0; --r) { c += sp[mt][r]; const bool valid = (64 * kb + 16 * mt + 4 * g4 + r) < qpos; pa[mt][r] = valid ? __builtin_amdgcn_exp2f(zz[mt][r] - c) : 0.f; }
                later += tot[mt];
            }
            R += later;
            bf16x8 pf[2];
#pragma unroll
            for (int ks = 0; ks < 2; ++ks) { u32x4 w; w.x = pk(pa[2 * ks][0], pa[2 * ks][1]); w.y = pk(pa[2 * ks][2], pa[2 * ks][3]); w.z = pk(pa[2 * ks + 1][0], pa[2 * ks + 1][1]); w.w = pk(pa[2 * ks + 1][2], pa[2 * ks + 1][3]);
                pf[ks] = __builtin_bit_cast(bf16x8, w); }
#pragma unroll
            for (int nt = 0; nt < 4; ++nt)
#pragma unroll
                for (int ks = 0; ks < 2; ++ks) {
                    const s16x4 lo = *(const LAS s16x4*)(sVt + (16 * nt + r16) * 72 + 32 * ks + 4 * g4), hi = *(const LAS s16x4*)(sVt + (16 * nt + r16) * 72 + 32 * ks + 16 + 4 * g4);
                    o[nt] = mfma16(pf[ks], __builtin_shufflevector(lo, hi, 0, 1, 2, 3, 4, 5, 6, 7), o[nt]);
                }
        }
        {
            float rm = R;
            rm = fminf(rm, __shfl_xor(rm, 1)); rm = fminf(rm, __shfl_xor(rm, 2)); rm = fminf(rm, __shfl_xor(rm, 4)); rm = fminf(rm, __shfl_xor(rm, 8)); rm = fminf(rm, __shfl_xor(rm, 16)); rm = fminf(rm, __shfl_xor(rm, 32));
            if (!wvalid) rm = 1e30f;
            if (rm > SB_THRESH * 1.44269504f) wdone = true;
            if (lane == 0) sRm[wave] = rm;
        }
        __syncthreads();
        float m = sRm[0];
#pragma unroll
        for (int w = 1; w < 8; ++w) m = fminf(m, sRm[w]);
        if (m > SB_THRESH * 1.44269504f) break;
    }
#undef ATT_LOADKV
    if (wvalid) {
#pragma unroll
        for (int nt = 0; nt < 4; ++nt)
#pragma unroll
            for (int r = 0; r < 4; ++r) OA[(size_t)(rowbase + 16 * wave + 4 * g4 + r) * DM + 512 + h * 64 + 16 * nt + r16] = (bf16_t)(pk(o[nt][r], 0.f) & 0xffffu);
    }
    __syncthreads();
}
DI void tail_reduce(int mode, int S, const int wv) {
    int tid_ = wv * 64 + mk_lane_id(); asm volatile("" : "+v"(tid_)); const int tid = tid_, lane = tid & 63, wave = tid >> 6;
    const int gw = blockIdx.x * 8 + wave, NGW = gridDim.x * 8;
    unsigned char* ws = ws_ptr();
    const bf16_t* PART = (const bf16_t*)(ws + WS_PART); bf16_t* HB = (bf16_t*)(ws + WS_HB);
    for (int rl = gw; rl < 1024; rl += NGW) {
        const int row = NP + rl;
        f32x4 acc[4];
#pragma unroll
        for (int j = 0; j < 4; ++j) acc[j] = (f32x4){0.f, 0.f, 0.f, 0.f};
#pragma unroll 4
        for (int s = 0; s < S; ++s) {
            const u32x2* p = (const u32x2*)(PART + (size_t)s * 1048576 + (size_t)rl * 1024);
#pragma unroll
            for (int j = 0; j < 4; ++j) { const u32x2 w = __builtin_nontemporal_load(p + lane + 64 * j); acc[j] += (f32x4){__uint_as_float(w.x << 16), __uint_as_float(w.x & 0xffff0000u), __uint_as_float(w.y << 16), __uint_as_float(w.y & 0xffff0000u)}; }
        }
        if (mode == 7) {
            const float rs = pg8::row_rs((const float*)(ws + WS_SS2), row);
            const bf16_t* PP = (const bf16_t*)(ws + WS_PP) + (size_t)row * DM; float* y = out_ptr() + O_Y + (size_t)row * DM;
#pragma unroll
            for (int j = 0; j < 4; ++j) { const u32x2 hw = ((const u32x2*)(HB + (size_t)row * DM))[lane + 64 * j]; const u32x2 pw = ((const u32x2*)PP)[lane + 64 * j];
                const f32x4 h = {__uint_as_float(hw.x << 16), __uint_as_float(hw.x & 0xffff0000u), __uint_as_float(hw.y << 16), __uint_as_float(hw.y & 0xffff0000u)};
                const f32x4 pp = {__uint_as_float(pw.x << 16), __uint_as_float(pw.x & 0xffff0000u), __uint_as_float(pw.y << 16), __uint_as_float(pw.y & 0xffff0000u)};
                const f32x4 t = acc[j] * (-rs);
                const f32x4 e = {__expf(t[0]), __expf(t[1]), __expf(t[2]), __expf(t[3])};
                ((f32x4*)y)[lane + 64 * j] = h + pp / (e + 1.f); }
        } else {
            const float* xs = in_ptr(1) + (size_t)rl * DM; float ss = 0.f;
#pragma unroll
            for (int j = 0; j < 4; ++j) { f32x4 base;
                if (mode == 4) base = ((const f32x4*)xs)[lane + 64 * j];
                else { const u32x2 hw = ((const u32x2*)(HB + (size_t)row * DM))[lane + 64 * j]; base = (f32x4){__uint_as_float(hw.x << 16), __uint_as_float(hw.x & 0xffff0000u), __uint_as_float(hw.y << 16), __uint_as_float(hw.y & 0xffff0000u)}; }
                const f32x4 v = acc[j] + base; ss += pg8::dot4(v);
                u32x2 o; o.x = pk(v[0], v[1]); o.y = pk(v[2], v[3]); ((u32x2*)(HB + (size_t)row * DM))[lane + 64 * j] = o; }
            ss = wave_sum(ss);
            float* SS = (float*)(ws + (mode == 4 ? WS_SS1 : WS_SS2));
            if (lane < 16) SS[(size_t)row * 16 + lane] = (lane == 0) ? ss : 0.f;
        }
    }
}
#ifndef PROBE_FLAGS
#define PROBE_FLAGS 0
#endif
#ifndef PROBE_REPEAT
#define PROBE_REPEAT -1
#endif
#ifndef MK_SPLIT
#define MK_SPLIT 0
#endif
__global__ void __launch_bounds__(512, 2) hybrid_fwd(Args a) {
    extern __shared__ __attribute__((aligned(16))) unsigned char lds_raw[];
    LAS unsigned char* lds = (LAS unsigned char*)lds_raw;
    cg::grid_group grid = cg::this_grid();
    const int lo = a.ph_lo, hi = a.ph_hi;
    volatile LAS unsigned* MISC = (volatile LAS unsigned*)(lds + MISC_OFF);
    const int wv = __builtin_amdgcn_readfirstlane((int)threadIdx.x >> 6);
    if (threadIdx.x < 2) MISC[threadIdx.x] = 0u;
    __syncthreads();
    const int bar_off = a.li * 16384;
    (void)xcd_barrier_post((unsigned*)(ws_ptr() + WS_CTL + bar_off), MISC, wv);
    if (lo < 0) grid.sync();
    const int G = gridDim.x, c = blockIdx.x;
    typedef pg8::bf16_t pb;
#define IN(k) (lo <= (k) && (k) < hi)
#define SEAM_NOW() do { XcdBarrier xb_; xb_.bar = (unsigned*)(ws_ptr() + WS_CTL + bar_off); xb_.x = xb_xcc_id(); xb_.st = MISC; xb_.wv = wv; xcd_barrier(xb_); } while (0)
#define SEAM(k) do { if (IN(k) && IN((k) + 1)) { XcdBarrier xb_; xb_.bar = (unsigned*)(ws_ptr() + WS_CTL + bar_off); xb_.x = xb_xcc_id(); xb_.st = MISC; xb_.wv = wv; xcd_barrier(xb_); } } while (0)
    if (IN(0)) phase0(a, lds, wv);
    SEAM(0);
    if (IN(1)) {
        unsigned char* const ws = ws_ptr(); (void)ws;
        { pg8::Gemm g{(const pb*)(ws + WS_U), (const pb*)(ws + WS_WIN), NT, NPROJ, DM, DM}; pg8::StaticOrder S; S.init(NT, NPROJ, G, c);
          pg8::EpiProj E{(pb*)(ws + WS_PROJ), (float*)(ws + WS_AB)};
          pg8::gemm_phase<pg8::EpiProj, pg8::StaticOrder, true, true, 1024, 1024>(lds, g, S, E, wv); }
    }
    SEAM(1);
    if (IN(2)) {
        unsigned char* const ws = ws_ptr(); (void)ws;
        const int flags = (lo == 0) ? a.pad : 0;
        if (!(flags & 4)) {
            if (c < NITEM) { int t_ = wv * 64 + mk_lane_id(); asm volatile("" : "+v"(t_)); DnIn d0; dn_fetch(c, t_, (const bf16_t*)(ws + WS_PROJ), in_ptr(2), in_ptr(10), d0); dn_stage(t_, lds, d0); }
            __syncthreads();
            for (int it = c; it < NITEM; it += G) dn_prep_item(a, lds, it, it + G, flags, wv);
        }
        if (!(flags & 2)) phase2_rows(a, wv);
    }
    SEAM(2);
    if (IN(3)) {
        unsigned char* const ws = ws_ptr(); (void)ws;
        if (G >= 128) {
            if (c < 64) dn_scan_chain(a, lds, c, wv);
            else { for (int ch = c; ch < 320; ch += G - 64) dn_scan_chain(a, lds, ch, wv);
                   for (int it = c - 64; it < 1280; it += G - 64) attn_item(a, lds, it, wv);
                 }
        } else {
            for (int w = c; w < 320 + 1280; w += G) { if (w < 320) dn_scan_chain(a, lds, w, wv); else attn_item(a, lds, w - 320, wv); }
        }
    }
    SEAM(3);
    if (IN(4)) {
        unsigned char* const ws = ws_ptr(); (void)ws;
        { pg8::Gemm g{(const pb*)(ws + WS_OA), (const pb*)(ws + WS_WOUT), NP, DM, DM, DM}; pg8::StaticOrder S; S.init(NP, DM, G, c);
          pg8::EpiRes<false> E{in_ptr(0), in_ptr(1), (pb*)(ws + WS_HB), (float*)(ws + WS_SS1)};
          pg8::gemm_phase<pg8::EpiRes<false>, pg8::StaticOrder, true, true, 1024, 1024>(lds, g, S, E, wv); }
        { pg8::Gemm g{(const pb*)(ws + WS_OA), (const pb*)(ws + WS_WOUT), NT, DM, 256, DM}; pg8::TailOrder T; T.init(4, G, c);
          pg8::EpiPart E{(pb*)(ws + WS_PART)};
          pg8::gemm_phase<pg8::EpiPart, pg8::TailOrder, true, true, 256, 1024>(lds, g, T, E, wv); }
        if (G >= 128) { if (c >= 64) {
          pg8::Gemm g{(const pb*)(ws + WS_PB), (const pb*)(ws + WS_WPJ), NT, DM, 256, 256}; pg8::StaticOrder S; S.init(NT, DM, G - 64, c - 64);
          pg8::EpiBf E{(pb*)(ws + WS_PP), DM};
          pg8::gemm_phase<pg8::EpiBf, pg8::StaticOrder, true, true, 256, 256>(lds, g, S, E, wv); } }
        else { pg8::Gemm g{(const pb*)(ws + WS_PB), (const pb*)(ws + WS_WPJ), NT, DM, 256, 256}; pg8::StaticOrder S; S.init(NT, DM, G, c);
          pg8::EpiBf E{(pb*)(ws + WS_PP), DM};
          pg8::gemm_phase<pg8::EpiBf, pg8::StaticOrder, true, true, 256, 256>(lds, g, S, E, wv); }
        SEAM_NOW(); tail_reduce(4, 4, wv);
    }
    SEAM(4);
    if (IN(5)) {
        unsigned char* const ws = ws_ptr(); (void)ws;
        pg8::Gemm g{(const pb*)(ws + WS_HB), (const pb*)(ws + WS_WUP), NT, FF, DM, DM}; pg8::StaticOrder S; S.init(NT, FF, G, c);
        pg8::EpiUp E{(const float*)(ws + WS_SS1), (pb*)(ws + WS_ACT)};
        pg8::gemm_phase<pg8::EpiUp, pg8::StaticOrder, true, true, 1024, 1024>(lds, g, S, E, wv);
    }
    SEAM(5);
    if (IN(6)) {
        unsigned char* const ws = ws_ptr(); (void)ws;
        { pg8::Gemm g{(const pb*)(ws + WS_ACT), (const pb*)(ws + WS_WDN), NP, DM, FF, FF}; pg8::StaticOrder S; S.init(NP, DM, G, c);
          pg8::EpiRes<true> E{nullptr, nullptr, (pb*)(ws + WS_HB), (float*)(ws + WS_SS2)};
          pg8::gemm_phase<pg8::EpiRes<true>, pg8::StaticOrder, true, true, 4096, 4096>(lds, g, S, E, wv); }
        { pg8::Gemm g{(const pb*)(ws + WS_ACT), (const pb*)(ws + WS_WDN), NT, DM, 256, FF}; pg8::TailOrder T; T.init(16, G, c);
          pg8::EpiPart E{(pb*)(ws + WS_PART)};
          pg8::gemm_phase<pg8::EpiPart, pg8::TailOrder, true, true, 256, 4096>(lds, g, T, E, wv); }
        SEAM_NOW(); tail_reduce(6, 16, wv);
    }
    SEAM(6);
    if (IN(7)) {
        unsigned char* const ws = ws_ptr(); (void)ws;
        { pg8::Gemm g{(const pb*)(ws + WS_HB), (const pb*)(ws + WS_WGT), NP, DM, DM, DM}; pg8::StaticOrder S; S.init(NP, DM, G, c);
          pg8::EpiOut E{(const float*)(ws + WS_SS2), (const pb*)(ws + WS_HB), (const pb*)(ws + WS_PP), out_ptr() + O_Y};
          pg8::gemm_phase<pg8::EpiOut, pg8::StaticOrder, true, true, 1024, 1024>(lds, g, S, E, wv); }
        { pg8::Gemm g{(const pb*)(ws + WS_HB), (const pb*)(ws + WS_WGT), NT, DM, 256, DM}; pg8::TailOrder T; T.init(4, G, c);
          pg8::EpiPart E{(pb*)(ws + WS_PART)};
          pg8::gemm_phase<pg8::EpiPart, pg8::TailOrder, true, true, 256, 1024>(lds, g, T, E, wv); }
        if (G >= 128) { if (c >= 64) p3_outputs(wv, c - 64, G - 64); } else p3_outputs(wv, c, G);
        SEAM_NOW(); tail_reduce(7, 4, wv);
    }
#undef IN
#undef SEAM
}

extern "C" void kernel_launch(void* const* d_in, const int* in_sizes, int n_in, void* d_out, int out_size, void* d_ws, size_t ws_size, hipStream_t stream) {
    static int grid = 0;
    if (grid == 0) {
        if (n_in != 23 || ws_size < WS_END) { fprintf(stderr, "kernel_launch: expected 23 inputs and >= %zu bytes of workspace (got %d, %zu)\n", (size_t)WS_END, n_in, ws_size); grid = -1; return; }
        int dev = 0, cus = 0, per_cu = 0;
        hipGetDevice(&dev); hipDeviceGetAttribute(&cus, hipDeviceAttributeMultiprocessorCount, dev);
        if (hipFuncSetAttribute((const void*)hybrid_fwd, hipFuncAttributeMaxDynamicSharedMemorySize, LDS_BYTES) != hipSuccess) { fprintf(stderr, "kernel_launch: hipFuncSetAttribute failed\n"); grid = -1; return; }
        if (hipOccupancyMaxActiveBlocksPerMultiprocessor(&per_cu, (const void*)hybrid_fwd, 512, LDS_BYTES) != hipSuccess || per_cu < 1) { fprintf(stderr, "kernel_launch: occupancy query says %d blocks per CU\n", per_cu); (void)hipGetLastError(); per_cu = 1; }
        grid = cus * 1;
        if (per_cu < 1) grid = -1;
    }
    if (grid < 0) return;
    if (hipMemsetAsync((char*)d_ws + WS_CTL, 0, CTL_BYTES, stream) != hipSuccess) { fprintf(stderr, "kernel_launch: hipMemsetAsync failed\n"); return; }
    Args a{};
    for (int i = 0; i < 23; ++i) a.in[i] = (const float*)d_in[i];
    a.out = (float*)d_out; a.ws = (unsigned char*)d_ws;
#if MK_SPLIT
    for (int k = 0; k < 8; ++k) { a.ph_lo = k; a.ph_hi = k + 1; hipLaunchKernelGGL(hybrid_fwd, dim3(grid), dim3(512), LDS_BYTES, stream, a); }
#else
#if PROBE_REPEAT >= 0
    for (int part = 0; part < 2; ++part) {
        a.ph_lo = part ? PROBE_REPEAT : 0; a.ph_hi = part ? 8 : PROBE_REPEAT + 1; a.li = part; a.pad = part ? 0 : PROBE_FLAGS;
        void* args[] = {&a};
        hipError_t e = hipLaunchCooperativeKernel((const void*)hybrid_fwd, dim3(grid), dim3(512), args, LDS_BYTES, stream);
        if (e != hipSuccess) fprintf(stderr, "cooperative launch failed: %s (grid %d)\n", hipGetErrorString(e), grid);
    }
#else
    a.ph_lo = 0; a.ph_hi = 8;
    void* args[] = {&a};
    hipError_t e = hipLaunchCooperativeKernel((const void*)hybrid_fwd, dim3(grid), dim3(512), args, LDS_BYTES, stream);
    if (e != hipSuccess) fprintf(stderr, "cooperative launch failed: %s (grid %d)\n", hipGetErrorString(e), grid);
#endif
#endif
}
```

```cpp
#include <hip/hip_runtime.h>
#include <hip/hip_cooperative_groups.h>
#include <cstdio>
#include <cstdint>
namespace cg = cooperative_groups;
__device__ __forceinline__ int mk_lane_id() { int l; asm volatile("v_mbcnt_lo_u32_b32 %0, -1, 0\n\tv_mbcnt_hi_u32_b32 %0, -1, %0" : "=v"(l)); return l; }
namespace pg8 {
#define PG8_LAS __attribute__((address_space(3)))
typedef unsigned short bf16_t;
typedef short bf16x8 __attribute__((ext_vector_type(8)));
typedef float f32x4 __attribute__((ext_vector_type(4)));
typedef unsigned u32x4 __attribute__((ext_vector_type(4)));
constexpr int BM = 256, BK = 64, HALF = 128, HTB = HALF * BK * 2  , STAGE_BYTES = 8 * HTB, NXCD = 8, WGM = 8;

__host__ __device__ __forceinline__ int lds_byte(int r, int c) { const int st = (r >> 4) * 2 + (c >> 5), rr = r & 15, cc = c & 31, ob = rr * 64 + cc * 2; return st * 1024 + (ob ^ (((ob >> 9) & 1) << 5)); }
__host__ __device__ __forceinline__ void stage_rc(int b, int& R, int& C) { const int st = b / 1024, sb = b % 1024, swz = sb ^ (((sb >> 9) & 1) << 5); R = (st >> 1) * 16 + swz / 64; C = (st & 1) * 32 + (swz % 64) / 2; }
__host__ __device__ __forceinline__ int perm32(int rho) { const int n = rho >> 4, i = rho & 15; return 8 * (i >> 2) + 4 * n + (i & 3); }

struct Unit { int pm, pn, ks; };
struct Gemm { const bf16_t* A; const bf16_t* Bt; int M, N, K, ld; };

struct StaticOrder {
    int nM, nN, nwg, G, c;
    __host__ __device__ void init(int M, int N, int G_, int c_) { nM = M / BM; nN = N / BM; nwg = nM * nN; G = G_; c = c_; }
    __host__ __device__ bool next(int i, Unit& u) const {
        const long L = (long)i * G + c; if (L >= nwg) return false;
        int wgid = (int)L; { const int q = nwg / NXCD, r = nwg % NXCD, xcd = wgid % NXCD, off = wgid / NXCD; wgid = (xcd < r ? xcd * (q + 1) : r * (q + 1) + (xcd - r) * q) + off; }
        const int nig = WGM * nN, gid = wgid / nig, fm = gid * WGM, gsz = (nM - fm) < WGM ? (nM - fm) : WGM;
        u.pm = fm + ((wgid % nig) % gsz); u.pn = (wgid % nig) / gsz; u.ks = 0; return true;
    }
    __device__ __forceinline__ void a_ready(const Unit&) const {}
    __device__ __forceinline__ void done(const Unit&) const {}
};

struct TailOrder {
    int S, G, c;
    __host__ __device__ void init(int S_, int G_, int c_) { S = S_; G = G_; c = c_; }
    __host__ __device__ bool next(int i, Unit& u) const { const int L = i * G + c; if (L >= 16 * S) return false; const int tile = L / S; u.ks = L - tile * S; u.pm = 64 + (tile >> 2); u.pn = tile & 3; return true; }
    __device__ __forceinline__ void a_ready(const Unit&) const {}
    __device__ __forceinline__ void done(const Unit&) const {}
};

typedef float f32x2_t __attribute__((ext_vector_type(2)));
typedef __bf16 bf16x2_t __attribute__((ext_vector_type(2)));
__device__ __forceinline__ unsigned cvt_pk_bf16(float lo, float hi) { unsigned r; asm volatile("v_cvt_pk_bf16_f32 %0, %1, %2" : "=v"(r) : "v"(lo), "v"(hi)); return r; }
__device__ __forceinline__ unsigned cvt_pk_bf16_safe(float lo, float hi) { f32x2_t v = {lo, hi}; bf16x2_t b = __builtin_convertvector(v, bf16x2_t); return __builtin_bit_cast(unsigned, b); }
constexpr int NT_ROWS = 17408, NP_ROWS = 16384;
__device__ __forceinline__ u32x4 pack8(const f32x4& a, const f32x4& b) { u32x4 w; w.x = cvt_pk_bf16(a[0], a[1]); w.y = cvt_pk_bf16(a[2], a[3]); w.z = cvt_pk_bf16(b[0], b[1]); w.w = cvt_pk_bf16(b[2], b[3]); return w; }
__device__ __forceinline__ float dot4(const f32x4& a) { return (a[0] * a[0] + a[1] * a[1]) + (a[2] * a[2] + a[3] * a[3]); }
__device__ __forceinline__ float row_rs(const float* SS, int row) {
    const f32x4* p = (const f32x4*)(SS + (size_t)row * 16); const f32x4 a = p[0], b = p[1], c = p[2], d = p[3];
    const float s = ((a[0] + a[1]) + (a[2] + a[3])) + ((b[0] + b[1]) + (b[2] + b[3])) + ((c[0] + c[1]) + (c[2] + c[3])) + ((d[0] + d[1]) + (d[2] + d[3]));
    return rsqrtf(s * (1.f / 1024.f) + 1e-6f); }

struct EpiProj {
    static constexpr bool PERM = true, AFTER_DRAIN = false;
    bf16_t* O; float* AB;
    __device__ __forceinline__ void operator()(const f32x4 (&acc)[2][2][4][2], const Unit& u, int wr, int wc, int fr, int fq) const {
        const int row0 = u.pm * BM + wr * 64 + fr;
        if (u.pn == 14) {
            if (wc == 0 && fq < 2) {
#pragma unroll
                for (int ai = 0; ai < 2; ++ai)
#pragma unroll
                    for (int m = 0; m < 4; ++m) { float* p = AB + (size_t)(row0 + ai * HALF + m * 16) * 16 + 8 * fq; *(f32x4*)p = acc[ai][0][m][0]; *(f32x4*)(p + 4) = acc[ai][0][m][1]; }
            }
            return;
        }
        const int col0 = u.pn * BM + wc * 32 + 8 * fq;
#pragma unroll
        for (int ai = 0; ai < 2; ++ai)
#pragma unroll
            for (int m = 0; m < 4; ++m) { bf16_t* rowp = O + (size_t)(row0 + ai * HALF + m * 16) * 3840 + col0;
#pragma unroll
                for (int bj = 0; bj < 2; ++bj) *(u32x4*)(rowp + bj * HALF) = pack8(acc[ai][bj][m][0], acc[ai][bj][m][1]); }
    }
};
struct EpiBf {
    static constexpr bool PERM = true, AFTER_DRAIN = false;
    bf16_t* O; int ldc;
    __device__ __forceinline__ void operator()(const f32x4 (&acc)[2][2][4][2], const Unit& u, int wr, int wc, int fr, int fq) const {
        const int row0 = u.pm * BM + wr * 64 + fr, col0 = u.pn * BM + wc * 32 + 8 * fq;
#pragma unroll
        for (int ai = 0; ai < 2; ++ai)
#pragma unroll
            for (int m = 0; m < 4; ++m) { bf16_t* rowp = O + (size_t)(row0 + ai * HALF + m * 16) * ldc + col0;
#pragma unroll
                for (int bj = 0; bj < 2; ++bj) *(u32x4*)(rowp + bj * HALF) = pack8(acc[ai][bj][m][0], acc[ai][bj][m][1]); }
    }
};
template <bool BF> struct EpiRes {
    static constexpr bool PERM = true, AFTER_DRAIN = false;
    const float* base0; const float* base1; bf16_t* Hb; float* SS;
    __device__ __forceinline__ void operator()(const f32x4 (&acc)[2][2][4][2], const Unit& u, int wr, int wc, int fr, int fq) const {
        const int row0 = u.pm * BM + wr * 64 + fr, col0 = u.pn * BM + wc * 32 + 8 * fq;
#pragma unroll
        for (int ai = 0; ai < 2; ++ai)
#pragma unroll
            for (int m = 0; m < 4; ++m) { const int row = row0 + ai * HALF + m * 16; float ss = 0.f;
#pragma unroll
                for (int bj = 0; bj < 2; ++bj) { bf16_t* hb = Hb + (size_t)row * 1024 + col0 + bj * HALF; f32x4 x0, x1;
                    if constexpr (BF) { const u32x4 pw = *(const u32x4*)hb;
                        x0[0] = __uint_as_float(pw.x << 16); x0[1] = __uint_as_float(pw.x & 0xffff0000u); x0[2] = __uint_as_float(pw.y << 16); x0[3] = __uint_as_float(pw.y & 0xffff0000u);
                        x1[0] = __uint_as_float(pw.z << 16); x1[1] = __uint_as_float(pw.z & 0xffff0000u); x1[2] = __uint_as_float(pw.w << 16); x1[3] = __uint_as_float(pw.w & 0xffff0000u); }
                    else { const float* rr = (row < NP_ROWS ? base0 + (size_t)row * 1024 : base1 + (size_t)(row - NP_ROWS) * 1024) + col0 + bj * HALF; x0 = *(const f32x4*)rr; x1 = *(const f32x4*)(rr + 4); }
                    const f32x4 v0 = acc[ai][bj][m][0] + x0, v1 = acc[ai][bj][m][1] + x1;
                    *(u32x4*)hb = pack8(v0, v1); ss += dot4(v0) + dot4(v1); }
                ss += __shfl_xor(ss, 16); ss += __shfl_xor(ss, 32); if (fq == 0) SS[(size_t)row * 16 + u.pn * 4 + wc] = ss; }
    }
};
struct EpiUp {
    static constexpr bool PERM = true, AFTER_DRAIN = false;
    const float* SS; bf16_t* O;
    __device__ __forceinline__ void operator()(const f32x4 (&acc)[2][2][4][2], const Unit& u, int wr, int wc, int fr, int fq) const {
        const int row0 = u.pm * BM + wr * 64 + fr, col0 = u.pn * BM + wc * 32 + 8 * fq;
#pragma unroll
        for (int ai = 0; ai < 2; ++ai)
#pragma unroll
            for (int m = 0; m < 4; ++m) { const int row = row0 + ai * HALF + m * 16; const float rs = row_rs(SS, row);
#pragma unroll
                for (int bj = 0; bj < 2; ++bj) { f32x4 v0 = acc[ai][bj][m][0] * rs, v1 = acc[ai][bj][m][1] * rs;
#pragma unroll
                    for (int e = 0; e < 4; ++e) { const float a = fmaxf(v0[e], 0.f), b = fmaxf(v1[e], 0.f); v0[e] = a * a; v1[e] = b * b; }
                    *(u32x4*)(O + (size_t)row * 4096 + col0 + bj * HALF) = pack8(v0, v1); } }
    }
};
struct EpiOut {
    static constexpr bool PERM = true, AFTER_DRAIN = false;
    const float* SS; const bf16_t* Hb; const bf16_t* PP; float* Y;
    __device__ __forceinline__ void operator()(const f32x4 (&acc)[2][2][4][2], const Unit& u, int wr, int wc, int fr, int fq) const {
        const int row0 = u.pm * BM + wr * 64 + fr, col0 = u.pn * BM + wc * 32 + 8 * fq;
#pragma unroll
        for (int ai = 0; ai < 2; ++ai)
#pragma unroll
            for (int m = 0; m < 4; ++m) { const int row = row0 + ai * HALF + m * 16; const float rs = row_rs(SS, row);
#pragma unroll
                for (int bj = 0; bj < 2; ++bj) { const size_t off = (size_t)row * 1024 + col0 + bj * HALF;
                    const u32x4 hw = *(const u32x4*)(Hb + off); const u32x4 pw = *(const u32x4*)(PP + off);
                    f32x4 h0, h1; h0[0] = __uint_as_float(hw.x << 16); h0[1] = __uint_as_float(hw.x & 0xffff0000u); h0[2] = __uint_as_float(hw.y << 16); h0[3] = __uint_as_float(hw.y & 0xffff0000u);
                    h1[0] = __uint_as_float(hw.z << 16); h1[1] = __uint_as_float(hw.z & 0xffff0000u); h1[2] = __uint_as_float(hw.w << 16); h1[3] = __uint_as_float(hw.w & 0xffff0000u);
                    f32x4 p0, p1; p0[0] = __uint_as_float(pw.x << 16); p0[1] = __uint_as_float(pw.x & 0xffff0000u); p0[2] = __uint_as_float(pw.y << 16); p0[3] = __uint_as_float(pw.y & 0xffff0000u);
                    p1[0] = __uint_as_float(pw.z << 16); p1[1] = __uint_as_float(pw.z & 0xffff0000u); p1[2] = __uint_as_float(pw.w << 16); p1[3] = __uint_as_float(pw.w & 0xffff0000u);
                    f32x4 y0, y1;
#pragma unroll
                    for (int e = 0; e < 4; ++e) { const float g0 = 1.f / (1.f + __expf(-acc[ai][bj][m][0][e] * rs)), g1 = 1.f / (1.f + __expf(-acc[ai][bj][m][1][e] * rs)); y0[e] = h0[e] + g0 * p0[e]; y1[e] = h1[e] + g1 * p1[e]; }
                    __builtin_nontemporal_store(y0, (f32x4*)(Y + off)); __builtin_nontemporal_store(y1, (f32x4*)(Y + off + 4)); } }
    }
};
struct EpiPart {
    static constexpr bool PERM = true, AFTER_DRAIN = false;
    bf16_t* P;
    __device__ __forceinline__ void operator()(const f32x4 (&acc)[2][2][4][2], const Unit& u, int wr, int wc, int fr, int fq) const {
        const int row0 = (u.pm - 64) * BM + wr * 64 + fr, col0 = u.pn * BM + wc * 32 + 8 * fq;
        bf16_t* base = P + (size_t)u.ks * 1048576;
#pragma unroll
        for (int ai = 0; ai < 2; ++ai)
#pragma unroll
            for (int m = 0; m < 4; ++m) { bf16_t* rowp = base + (size_t)(row0 + ai * HALF + m * 16) * 1024 + col0;
#pragma unroll
                for (int bj = 0; bj < 2; ++bj) *(u32x4*)(rowp + bj * HALF) = pack8(acc[ai][bj][m][0], acc[ai][bj][m][1]); }
    }
};
template <class Epi, class Sched, bool ALIGN_EPI = false, bool SP2 = false, int KT = 0, int LDT = 0>
__device__ __forceinline__ void gemm_phase(PG8_LAS unsigned char* lds, const Gemm g, const Sched& S, const Epi& E, const int wv  ) {
    int tid_ = wv * 64 + mk_lane_id(); asm volatile("" : "+v"(tid_));
    const int tid = tid_, wid = __builtin_amdgcn_readfirstlane(tid >> 6), lane = tid & 63, wr = wid >> 2, wc = wid & 3, fr = lane & 15, fq = lane >> 4;
    const int K = KT ? KT : g.K, LD = LDT ? LDT : g.ld, nt = K / BK;
    unsigned voffA[2], voffB[2];
#pragma unroll
    for (int i = 0; i < 2; ++i) { int R, C; stage_rc(tid * 16 + i * 8192, R, C); const int Rb = Epi::PERM ? ((R & ~31) + perm32(R & 31)) : R;
        voffA[i] = (unsigned)(R * LD + C) * 2u; voffB[i] = (unsigned)(Rb * LD + C) * 2u; }
    const size_t kstep = (size_t)(BK * 2);
    const size_t hstep = (size_t)HALF * LD * 2;
    const size_t tstep = 2 * hstep;
    const unsigned ldsw = (unsigned)wid * 1024u;
    const int aoff = lds_byte(wr * 64 + fr, fq * 8), boff = lds_byte(wc * 32 + fr, fq * 8);
#define PG8_SA(b, h) (((b) * 2 + (h)) * HTB)
#define PG8_SB(b, h) ((4 + (b) * 2 + (h)) * HTB)
#define PG8_STAGE(bufoff, gbase, voff) do { _Pragma("unroll") for (int _i = 0; _i < 2; ++_i) \
        __builtin_amdgcn_global_load_lds((const unsigned*)((const char*)(gbase) + (voff)[_i]), (PG8_LAS unsigned*)(lds + (bufoff) + ldsw + _i * 8192), 16, 0, 0); } while (0)
#define PG8_LDA(dst, b, h) do { _Pragma("unroll") for (int m = 0; m < 4; ++m) _Pragma("unroll") for (int k = 0; k < 2; ++k) dst[m][k] = *(const PG8_LAS bf16x8*)(lds + PG8_SA(b, h) + aoff + m * 2048 + k * 1024); } while (0)
#define PG8_LDB(dst, b, h) do { _Pragma("unroll") for (int n = 0; n < 2; ++n) _Pragma("unroll") for (int k = 0; k < 2; ++k) dst[n][k] = *(const PG8_LAS bf16x8*)(lds + PG8_SB(b, h) + boff + n * 2048 + k * 1024); } while (0)
#define PG8_MMA(ai, bj, At, Bt) do { __builtin_amdgcn_s_setprio(1); _Pragma("unroll") for (int m = 0; m < 4; ++m) _Pragma("unroll") for (int n = 0; n < 2; ++n) _Pragma("unroll") for (int k = 0; k < 2; ++k) \
        acc[ai][bj][m][n] = __builtin_amdgcn_mfma_f32_16x16x32_bf16(Bt[n][k], At[m][k], acc[ai][bj][m][n], 0, 0, 0); __builtin_amdgcn_s_setprio(0); } while (0)
#define PG8_WAIT_V(n) asm volatile("s_waitcnt vmcnt(" #n ")" ::: "memory")
#define PG8_WAIT_L(n) asm volatile("s_waitcnt lgkmcnt(" #n ")" ::: "memory")
#define PG8_BAR __builtin_amdgcn_s_barrier()
#define PG8_SCHED __builtin_amdgcn_sched_barrier(0)
    Unit cur, nxt; int ui = 0;
    if (!S.next(0, cur)) return;
    f32x4 acc[2][2][4][2];
#pragma unroll
    for (int a = 0; a < 2; ++a)
#pragma unroll
        for (int b = 0; b < 2; ++b)
#pragma unroll
            for (int m = 0; m < 4; ++m)
#pragma unroll
                for (int n = 0; n < 2; ++n) acc[a][b][m][n] = (f32x4){0.f, 0.f, 0.f, 0.f};
    bf16x8 At[4][2], B0[2][2], B1[2][2];
    const char* cA = (const char*)g.A + (size_t)cur.pm * tstep + (size_t)cur.ks * K * 2; const char* cB = (const char*)g.Bt + (size_t)cur.pn * tstep + (size_t)cur.ks * K * 2;
    S.a_ready(cur);
    if constexpr (SP2) {
        PG8_STAGE(PG8_SB(0, 0), cB, voffB); PG8_STAGE(PG8_SB(0, 1), cB + hstep, voffB); PG8_STAGE(PG8_SA(0, 0), cA, voffA); PG8_STAGE(PG8_SA(0, 1), cA + hstep, voffA);
        if (wr == 1) PG8_BAR;
        PG8_WAIT_V(2); PG8_BAR;
        PG8_STAGE(PG8_SB(1, 0), cB + kstep, voffB); PG8_STAGE(PG8_SA(1, 0), cA + kstep, voffA); PG8_STAGE(PG8_SB(1, 1), cB + hstep + kstep, voffB);
        PG8_WAIT_V(6); PG8_BAR;
    } else {
        PG8_STAGE(PG8_SB(0, 0), cB, voffB); PG8_STAGE(PG8_SA(0, 0), cA, voffA); PG8_STAGE(PG8_SB(0, 1), cB + hstep, voffB); PG8_STAGE(PG8_SA(0, 1), cA + hstep, voffA);
        if (wr == 1) PG8_BAR;
        PG8_WAIT_V(4); PG8_BAR;
        PG8_STAGE(PG8_SB(1, 0), cB + kstep, voffB); PG8_STAGE(PG8_SA(1, 0), cA + kstep, voffA); PG8_STAGE(PG8_SB(1, 1), cB + hstep + kstep, voffB);
        PG8_WAIT_V(6); PG8_BAR;
    }
    for (;;) {
        const bool has_next = S.next(ui + 1, nxt);
        const char* nA = has_next ? (const char*)g.A + (size_t)nxt.pm * tstep + (size_t)nxt.ks * K * 2 : cA; const char* nB = has_next ? (const char*)g.Bt + (size_t)nxt.pn * tstep + (size_t)nxt.ks * K * 2 : cB;
        for (int t = 0; t < nt; t += 2) {
            const bool last = (t == nt - 2);
            const char* a1 = cA + (size_t)(t + 1) * kstep;
            const char* a2 = last ? nA : cA + (size_t)(t + 2) * kstep; const char* b2 = last ? nB : cB + (size_t)(t + 2) * kstep;
            const char* a3 = a2 + kstep; const char* b3 = b2 + kstep;
            if (last && has_next) S.a_ready(nxt);
            if constexpr (SP2) {
            PG8_LDB(B0, 0, 0); PG8_LDB(B1, 0, 1); PG8_SCHED; PG8_LDA(At, 0, 0); PG8_STAGE(PG8_SA(1, 1), a1 + hstep, voffA);
            PG8_WAIT_V(8); PG8_WAIT_L(0); PG8_BAR; PG8_MMA(0, 0, At, B0); PG8_MMA(0, 1, At, B1); PG8_BAR; PG8_SCHED;
            PG8_LDA(At, 0, 1); PG8_STAGE(PG8_SB(0, 0), b2, voffB); PG8_STAGE(PG8_SB(0, 1), b2 + hstep, voffB); PG8_STAGE(PG8_SA(0, 0), a2, voffA);
            PG8_WAIT_V(8); PG8_WAIT_L(0); PG8_BAR; PG8_MMA(1, 0, At, B0); PG8_MMA(1, 1, At, B1); PG8_BAR; PG8_SCHED;
            PG8_LDB(B0, 1, 0); PG8_LDB(B1, 1, 1); PG8_SCHED; PG8_LDA(At, 1, 0); PG8_STAGE(PG8_SA(0, 1), a2 + hstep, voffA);
            PG8_WAIT_V(8); PG8_WAIT_L(0); PG8_BAR; PG8_MMA(0, 0, At, B0); PG8_MMA(0, 1, At, B1); PG8_BAR; PG8_SCHED;
            PG8_LDA(At, 1, 1); PG8_STAGE(PG8_SB(1, 0), b3, voffB); PG8_STAGE(PG8_SB(1, 1), b3 + hstep, voffB); PG8_STAGE(PG8_SA(1, 0), a3, voffA);
            PG8_WAIT_V(8); PG8_WAIT_L(0); PG8_BAR; PG8_MMA(1, 0, At, B0); PG8_MMA(1, 1, At, B1); PG8_BAR; PG8_SCHED;
            } else {
            PG8_LDB(B0, 0, 0); PG8_SCHED; PG8_LDA(At, 0, 0); PG8_STAGE(PG8_SA(1, 1), a1 + hstep, voffA);
            PG8_WAIT_L(8); PG8_BAR; PG8_WAIT_L(0); PG8_MMA(0, 0, At, B0); PG8_BAR; PG8_SCHED;
            PG8_LDB(B1, 0, 1); PG8_STAGE(PG8_SB(0, 0), b2, voffB);
            PG8_BAR; PG8_WAIT_L(0); PG8_MMA(0, 1, At, B1); PG8_BAR;
            PG8_LDA(At, 0, 1); PG8_STAGE(PG8_SA(0, 0), a2, voffA);
            PG8_BAR; PG8_WAIT_L(0); PG8_MMA(1, 0, At, B0); PG8_BAR; PG8_SCHED;
            PG8_STAGE(PG8_SB(0, 1), b2 + hstep, voffB);
            PG8_WAIT_V(6); PG8_BAR; PG8_MMA(1, 1, At, B1); PG8_BAR;
            PG8_LDB(B0, 1, 0); PG8_SCHED; PG8_LDA(At, 1, 0); PG8_STAGE(PG8_SA(0, 1), a2 + hstep, voffA);
            PG8_WAIT_L(8); PG8_BAR; PG8_WAIT_L(0); PG8_MMA(0, 0, At, B0); PG8_BAR; PG8_SCHED;
            PG8_LDB(B1, 1, 1); PG8_STAGE(PG8_SB(1, 0), b3, voffB);
            PG8_BAR; PG8_WAIT_L(0); PG8_MMA(0, 1, At, B1); PG8_BAR;
            PG8_LDA(At, 1, 1); PG8_STAGE(PG8_SA(1, 0), a3, voffA);
            PG8_BAR; PG8_WAIT_L(0); PG8_MMA(1, 0, At, B0); PG8_BAR; PG8_SCHED;
            PG8_STAGE(PG8_SB(1, 1), b3 + hstep, voffB);
            PG8_WAIT_V(6); PG8_BAR; PG8_MMA(1, 1, At, B1); PG8_BAR;
            }
        }
        if constexpr (ALIGN_EPI) { if (wr == 0) PG8_BAR; }
        if constexpr (!Epi::AFTER_DRAIN) { E(acc, cur, wr, wc, fr, fq); S.done(cur); }
        if (!has_next) break;
#pragma unroll
        for (int a = 0; a < 2; ++a)
#pragma unroll
            for (int b = 0; b < 2; ++b)
#pragma unroll
                for (int m = 0; m < 4; ++m)
#pragma unroll
                    for (int n = 0; n < 2; ++n) acc[a][b][m][n] = (f32x4){0.f, 0.f, 0.f, 0.f};
        cur = nxt; cA = nA; cB = nB; ++ui;
        if constexpr (ALIGN_EPI) { if (wr == 1) PG8_BAR; }
    }
    PG8_WAIT_V(0);
    if constexpr (!ALIGN_EPI) { if (wr == 0) PG8_BAR; }
    PG8_BAR;
    if constexpr (Epi::AFTER_DRAIN) { E.fused(acc, cur, wr, wc, fr, fq, lds, wid, lane); S.done(cur); }
#undef PG8_SA
#undef PG8_SB
#undef PG8_STAGE
#undef PG8_LDA
#undef PG8_LDB
#undef PG8_MMA
#undef PG8_WAIT_V
#undef PG8_WAIT_L
#undef PG8_BAR
#undef PG8_SCHED
}
}
#define DI __device__ __forceinline__
#define LAS __attribute__((address_space(3)))
typedef unsigned short bf16_t;
typedef short bf16x8 __attribute__((ext_vector_type(8)));
typedef short s16x4 __attribute__((ext_vector_type(4)));
typedef float f32x4 __attribute__((ext_vector_type(4)));
typedef unsigned u32x4 __attribute__((ext_vector_type(4)));
typedef unsigned u32x2 __attribute__((ext_vector_type(2)));
constexpr int NT = 17408, NP = 16384, DM = 1024, NPROJ = 3840, FF = 4096;
constexpr int C_Z = 1536, C_SBQ = 2048, C_SBK = 2560, C_SBV = 3072;
constexpr int NITEM = 2048 + 256;
constexpr float EPS = 1e-6f;
constexpr float SB_THRESH = 40.f;
constexpr size_t O_Y = 0, O_CONVP = 17825792, O_DELTAP = 17862656, O_KP = 18124800, O_VP = 26513408, O_CONVS = 34902016, O_DELTAS = 35049472, O_KS = 36098048, O_VS = 36622336;
constexpr size_t al4k(size_t x) { return (x + 4095) & ~(size_t)4095; }
constexpr size_t WS_CTL = 0, CTL_BYTES = 65536;
constexpr size_t WS_SS1 = CTL_BYTES, WS_SS2 = al4k(WS_SS1 + (size_t)NT * 64), WS_GL = al4k(WS_SS2 + (size_t)NT * 64), WS_AB = al4k(WS_GL + (size_t)NITEM * 4);
constexpr size_t WS_WIN = al4k(WS_AB + (size_t)NT * 64), WS_WOUT = al4k(WS_WIN + (size_t)NPROJ * DM * 2), WS_WUP = al4k(WS_WOUT + (size_t)DM * DM * 2), WS_WDN = al4k(WS_WUP + (size_t)FF * DM * 2);
constexpr size_t WS_WGT = al4k(WS_WDN + (size_t)DM * FF * 2), WS_WPJ = al4k(WS_WGT + (size_t)DM * DM * 2), WS_U = al4k(WS_WPJ + (size_t)DM * 256 * 2), WS_PB = al4k(WS_U + (size_t)NT * DM * 2);
constexpr size_t WS_PROJ = al4k(WS_PB + (size_t)NT * 256 * 2), WS_PP = al4k(WS_PROJ + (size_t)NT * NPROJ * 2), WS_QN = al4k(WS_PP + (size_t)NT * DM * 2), WS_KN = al4k(WS_QN + (size_t)NT * 512 * 2);
constexpr size_t WS_DN = al4k(WS_KN + (size_t)NT * 512 * 2), WS_OA = al4k(WS_DN + (size_t)NITEM * 40960), WS_HF = al4k(WS_OA + (size_t)NT * DM * 2), WS_HB = al4k(WS_HF + (size_t)NT * DM * 4);
constexpr size_t WS_ACT = al4k(WS_HB + (size_t)NT * DM * 2), WS_PART = al4k(WS_ACT + (size_t)NT * FF * 2), WS_END = al4k(WS_PART + (size_t)16 * 1048576 * 4);
constexpr int LDS_BYTES = 147456, MISC_OFF = 143360;

#define LDS_WAIT() asm volatile("s_waitcnt lgkmcnt(0)" ::: "memory")
DI unsigned pk(float lo, float hi) { return pg8::cvt_pk_bf16_safe(lo, hi); }
DI void unpack8(const u32x4 w, float* f) {
    f[0] = __uint_as_float(w.x << 16); f[1] = __uint_as_float(w.x & 0xffff0000u); f[2] = __uint_as_float(w.y << 16); f[3] = __uint_as_float(w.y & 0xffff0000u);
    f[4] = __uint_as_float(w.z << 16); f[5] = __uint_as_float(w.z & 0xffff0000u); f[6] = __uint_as_float(w.w << 16); f[7] = __uint_as_float(w.w & 0xffff0000u); }
DI u32x4 pack8f(const float* f) { u32x4 w; w.x = pk(f[0], f[1]); w.y = pk(f[2], f[3]); w.z = pk(f[4], f[5]); w.w = pk(f[6], f[7]); return w; }
DI float wave_sum(float v) {
#pragma unroll
    for (int o = 1; o < 64; o <<= 1) v += __shfl_xor(v, o);
    return v; }
DI float quad_xor1(float v) { return __int_as_float(__builtin_amdgcn_update_dpp(0, __float_as_int(v), 0xB1, 0xF, 0xF, true)); }
DI float quad_xor2(float v) { return __int_as_float(__builtin_amdgcn_update_dpp(0, __float_as_int(v), 0x4E, 0xF, 0xF, true)); }
DI float sum8(float v) { v += quad_xor1(v); v += quad_xor2(v); v += __shfl_xor(v, 4); return v; }
DI f32x4 mfma16(bf16x8 a, bf16x8 b, f32x4 c) { return __builtin_amdgcn_mfma_f32_16x16x32_bf16(a, b, c, 0, 0, 0); }

struct Args { const float* in[23]; float* out; unsigned char* ws; int ph_lo, ph_hi, li, pad; };
DI unsigned long long karg64(int byte_off) { const __attribute__((address_space(4))) char* kp = (const __attribute__((address_space(4))) char*)__builtin_amdgcn_kernarg_segment_ptr();
    return *(const volatile __attribute__((address_space(4))) unsigned long long*)(kp + byte_off); }
DI const float* in_ptr(int i) { return (const float*)karg64(8 * i); }
DI float* out_ptr() { return (float*)karg64(184); }
DI unsigned char* ws_ptr() { return (unsigned char*)karg64(192); }

DI int win_dest_row(int n) { return n < 2048 ? n : (n < 2064 ? 3584 + (n - 2048) : n - 16); }
DI void transpose_item(const float* __restrict__ W, int K, int N, bf16_t* WT, const float* __restrict__ gk, bool winmap, LAS float* scr, int item, int lane) {
    const int nblk = (N + 63) >> 6, kb = item / nblk, nb = item - kb * nblk, k0 = 64 * kb, n0 = 64 * nb;
    const int q4 = 4 * (lane & 15), nq = n0 + q4;
#pragma unroll 4
    for (int i = 0; i < 16; ++i) { const int kk = 4 * i + (lane >> 4); f32x4 w = {0.f, 0.f, 0.f, 0.f}; if (nq < N) w = *(const f32x4*)(W + (size_t)(k0 + kk) * N + nq); if (gk) w = w * gk[k0 + kk];
        LAS float* d = scr + kk * 65 + q4; d[0] = w[0]; d[1] = w[1]; d[2] = w[2]; d[3] = w[3]; }
    LDS_WAIT();
    const int c = lane & 7;
#pragma unroll
    for (int j = 0; j < 8; ++j) { const int nl = (lane >> 3) + 8 * j, n = n0 + nl; const LAS float* s = scr + (8 * c) * 65 + nl;
        if (n < N) { u32x4 o; o.x = pk(s[0 * 65], s[1 * 65]); o.y = pk(s[2 * 65], s[3 * 65]); o.z = pk(s[4 * 65], s[5 * 65]); o.w = pk(s[6 * 65], s[7 * 65]);
            const int dr = winmap ? win_dest_row(n) : n; *(u32x4*)(WT + (size_t)dr * K + k0 + 8 * c) = o; } }
    LDS_WAIT();
}
DI void phase0(const Args& a, LAS unsigned char* lds, const int wv) {
    int tid_ = wv * 64 + mk_lane_id(); asm volatile("" : "+v"(tid_)); const int tid = tid_, lane = tid & 63, wave = tid >> 6;
    const int gw = blockIdx.x * 8 + wave, NGW = gridDim.x * 8;
    unsigned char* ws = ws_ptr();
    LAS float* scr = (LAS float*)(lds + wave * 16896);
    constexpr int I_IN = 16 * 57, I_OUT = 16 * 16, I_UP = 16 * 64, I_DN = 64 * 16, I_GT = 16 * 16, I_PJ = 4 * 16;
    for (int it = gw; it < I_IN + I_OUT + I_UP + I_DN + I_GT + I_PJ; it += NGW) {
        int r = it;
        if (r < I_IN) { transpose_item(in_ptr(9), DM, 3600, (bf16_t*)(ws + WS_WIN), nullptr, true, scr, r, lane); continue; } r -= I_IN;
        if (r < I_OUT) { transpose_item(in_ptr(16), DM, DM, (bf16_t*)(ws + WS_WOUT), nullptr, false, scr, r, lane); continue; } r -= I_OUT;
        if (r < I_UP) { transpose_item(in_ptr(18), DM, FF, (bf16_t*)(ws + WS_WUP), in_ptr(17), false, scr, r, lane); continue; } r -= I_UP;
        if (r < I_DN) { transpose_item(in_ptr(19), FF, DM, (bf16_t*)(ws + WS_WDN), nullptr, false, scr, r, lane); continue; } r -= I_DN;
        if (r < I_GT) { transpose_item(in_ptr(21), DM, DM, (bf16_t*)(ws + WS_WGT), in_ptr(20), false, scr, r, lane); continue; } r -= I_GT;
        transpose_item(in_ptr(22), 256, DM, (bf16_t*)(ws + WS_WPJ), nullptr, false, scr, r, lane);
    }
    const float* gmix = in_ptr(8); const float* const xP = in_ptr(0); const float* const xS = in_ptr(1); const float* const pP = in_ptr(6); const float* const pS = in_ptr(7);
    bf16_t* U = (bf16_t*)(ws + WS_U); bf16_t* PB = (bf16_t*)(ws + WS_PB);
    for (int rb = gw; rb < NT; rb += 4 * NGW) {
        f32x4 v[4][4], pv[4];
#pragma unroll
        for (int t = 0; t < 4; ++t) { const int r = rb + t * NGW; if (r < NT) {
            const float* xr = r < NP ? xP + (size_t)r * DM : xS + (size_t)(r - NP) * DM;
#pragma unroll
            for (int j = 0; j < 4; ++j) v[t][j] = ((const f32x4*)xr)[lane + 64 * j];
            const float* pr = r < NP ? pP + (size_t)r * 256 : pS + (size_t)(r - NP) * 256;
            pv[t] = ((const f32x4*)pr)[lane]; } }
#pragma unroll
        for (int t = 0; t < 4; ++t) { const int r = rb + t * NGW; if (r < NT) {
            float ss = 0.f;
#pragma unroll
            for (int j = 0; j < 4; ++j) ss += pg8::dot4(v[t][j]);
            const float rs = rsqrtf(wave_sum(ss) * (1.f / DM) + EPS);
#pragma unroll
            for (int j = 0; j < 4; ++j) { const f32x4 g = ((const f32x4*)gmix)[lane + 64 * j]; u32x2 o; o.x = pk(v[t][j][0] * rs * g[0], v[t][j][1] * rs * g[1]); o.y = pk(v[t][j][2] * rs * g[2], v[t][j][3] * rs * g[3]);
                *(u32x2*)(U + (size_t)r * DM + 4 * (lane + 64 * j)) = o; }
            u32x2 po; po.x = pk(pv[t][0], pv[t][1]); po.y = pk(pv[t][2], pv[t][3]);
            *(u32x2*)(PB + (size_t)r * 256 + 4 * lane) = po; } }
    }
}
#define XB_TMO      128
#define XB_XCNT(j)  (256  + 64 * (j))
#define XB_XSUB(j)  (1280 + 64 * (j))
#define XB_XGEN(j)  (2304 + 64 * (j))
#define XB_TOP      3328
#define XB_TOPGEN   3392
#define XCD_BAR_WORDS 3456
#define XB_SPIN_CAP (1u << 18)

__device__ __forceinline__ unsigned xb_ld(unsigned* p)              { return __hip_atomic_load(p, __ATOMIC_RELAXED, __HIP_MEMORY_SCOPE_AGENT); }
__device__ __forceinline__ unsigned xb_add(unsigned* p, unsigned v) { return __hip_atomic_fetch_add(p, v, __ATOMIC_RELAXED, __HIP_MEMORY_SCOPE_AGENT); }
__device__ __forceinline__ unsigned xb_xcc_id() { return (unsigned)__builtin_amdgcn_s_getreg((3 << 11) | 20) & 0xFu; }
#define XB_SPIN(cond, bar) do { unsigned _sp = 0; while (cond) { __builtin_amdgcn_s_sleep(1); \
    if ((++_sp & 255u) == 0u) { if (xb_ld(&(bar)[XB_TMO])) break; if (_sp > XB_SPIN_CAP) { atomicAdd(&(bar)[XB_TMO], 1u); break; } } } } while (0)

struct XcdBarrier {
    unsigned* bar; unsigned x; int wv;
    volatile LAS unsigned* st;
};

__device__ __forceinline__ XcdBarrier xcd_barrier_post(unsigned* bar, volatile LAS unsigned* st, int wv) {
    XcdBarrier b; b.bar = bar; b.x = xb_xcc_id(); b.st = st; b.wv = wv;
    if (wv == 0 && mk_lane_id() == 0) (void)xb_add(&bar[XB_XCNT(b.x)], 1u);
    return b;
}
__device__ __forceinline__ void xcd_barrier_complete(unsigned* bar, unsigned x, unsigned& nloc, unsigned& nx) {
    const unsigned G = gridDim.x * gridDim.y * gridDim.z;
    unsigned sum, cnt, mine, sp = 0u;
    for (;;) {
        sum = 0u; cnt = 0u; mine = 0u;
#pragma unroll
        for (unsigned j = 0; j < 16; ++j) { const unsigned c = xb_ld(&bar[XB_XCNT(j)]); sum += c; cnt += (c > 0u) ? 1u : 0u; mine = (j == x) ? c : mine; }
        if (sum == G) break;
        __builtin_amdgcn_s_sleep(1);
        if ((++sp & 255u) == 0u) { if (xb_ld(&bar[XB_TMO])) break; if (sp > XB_SPIN_CAP) { atomicAdd(&bar[XB_TMO], 1u); break; } }
    }
    nloc = mine > 0u ? mine : 1u; nx = cnt > 0u ? cnt : 1u;
}

__device__ __forceinline__ void xcd_barrier(const XcdBarrier& b) {
    asm volatile("s_waitcnt vmcnt(0)" ::: "memory");
    __syncthreads();
    if (b.wv == 0 && mk_lane_id() == 0) {
        unsigned* bar = b.bar;
        __builtin_amdgcn_s_waitcnt(0);
        unsigned nloc = b.st[0], nx = b.st[1];
        if (nloc == 0u) { xcd_barrier_complete(bar, b.x, nloc, nx); b.st[0] = nloc; b.st[1] = nx; }
        const unsigned old = xb_add(&bar[XB_XSUB(b.x)], 1u);
        const unsigned gen = old / nloc;
        if (old + 1u == (gen + 1u) * nloc) {
            __builtin_amdgcn_fence(__ATOMIC_RELEASE, "agent");
            asm volatile("s_waitcnt vmcnt(0)" ::: "memory");
            const unsigned og = xb_add(&bar[XB_TOP], 1u);
            const unsigned tg = og / nx;
            if (og + 1u == (tg + 1u) * nx) xb_add(&bar[XB_TOPGEN], 1u);
            else XB_SPIN(xb_ld(&bar[XB_TOPGEN]) == tg, bar);
            __builtin_amdgcn_fence(__ATOMIC_ACQUIRE, "agent");
            xb_add(&bar[XB_XGEN(b.x)], 1u);
            asm volatile("s_waitcnt vmcnt(0)" ::: "memory");
        } else {
            XB_SPIN(xb_ld(&bar[XB_XGEN(b.x)]) == gen, bar);
            __builtin_amdgcn_fence(__ATOMIC_ACQUIRE, "agent");
            asm volatile("s_waitcnt vmcnt(0)" ::: "memory");
        }
    }
    __syncthreads();
}
struct DnIn { u32x4 p[4]; f32x4 w; };
DI void dn_fetch(int item, int tid, const bf16_t* PROJ, const float* cconv, const float* convw, DnIn& d) {
    int b, h, n, row0, L; bool samp;
    if (item < 2048) { b = item >> 8; h = (item >> 5) & 7; n = item & 31; row0 = b * 2048 + n * 64; L = 64; samp = false; }
    else { const int sid = item - 2048; b = sid >> 3; h = sid & 7; n = 0; row0 = NP + b * 32; L = 32; samp = true; }
#pragma unroll
    for (int k = 0; k < 4; ++k) {
        const int q = tid + 512 * k; u32x4 v = {0u, 0u, 0u, 0u};
        if (q < 1608) { const int part = q / 536, rem = q - part * 536, row = rem >> 3, pc = rem & 7, xi = row - 3, col = part * 512 + h * 64 + pc * 8;
            if (xi < L) {
                if (xi >= 0 || (!samp && n > 0)) v = *(const u32x4*)(PROJ + (size_t)(row0 + xi) * NPROJ + col);
                else if (samp) { const float* cp = cconv + (size_t)(b * 3 + row) * 1536 + col; const f32x4 c0 = *(const f32x4*)cp, c1 = *(const f32x4*)(cp + 4); v = pg8::pack8(c0, c1); }
            } }
        d.p[k] = v;
    }
    d.w = (f32x4){0.f, 0.f, 0.f, 0.f};
    if (tid < 192) { const int tap = tid / 48, r = tid - tap * 48, part = r >> 4, c4 = r & 15; d.w = *(const f32x4*)(convw + (size_t)tap * 1536 + part * 512 + h * 64 + c4 * 4); }
}
DI void dn_stage(int tid, LAS unsigned char* lds, const DnIn& d) {
#pragma unroll
    for (int k = 0; k < 4; ++k) { const int q = tid + 512 * k; if (q < 1608) { const int part = q / 536, rem = q - part * 536, row = rem >> 3, pc = rem & 7;
        *(LAS u32x4*)(lds + 107008 + (part * 67 + row) * 144 + pc * 16) = d.p[k]; } }
    if (tid < 192) { const int tap = tid / 48, r = tid - tap * 48, part = r >> 4, c4 = r & 15; *(LAS f32x4*)(lds + 135952 + (tap * 192 + part * 64 + c4 * 4) * 4) = d.w; }
}
DI void dn_prep_item(const Args& a, LAS unsigned char* lds, int item, int next_item, int flags, const int wv) {
    int tid_ = wv * 64 + mk_lane_id(); asm volatile("" : "+v"(tid_)); const int tid = tid_, lane = tid & 63, wave = tid >> 6;
    unsigned char* ws = ws_ptr();
    const bf16_t* PROJ = (const bf16_t*)(ws + WS_PROJ); const float* AB = (const float*)(ws + WS_AB);
    int b, h, n, row0, L; bool samp;
    if (item < 2048) { b = item >> 8; h = (item >> 5) & 7; n = item & 31; row0 = b * 2048 + n * 64; L = 64; samp = false; }
    else { const int sid = item - 2048; b = sid >> 3; h = sid & 7; n = 0; row0 = NP + b * 32; L = 32; samp = true; }
    LAS bf16_t* sQ = (LAS bf16_t*)(lds);
    LAS bf16_t* sK = (LAS bf16_t*)(lds + 9216);
    LAS float* sA = (LAS float*)(lds + 18432);
    LAS float* sR = (LAS float*)(lds + 35840);
    LAS float* sG = (LAS float*)(lds + 69632);
    LAS bf16_t* sO = (LAS bf16_t*)(lds + 70144);
    unsigned char* dn = ws + WS_DN + (size_t)item * 40960;
    const int i = tid >> 3, cg = tid & 7;
    const float* const cconv = in_ptr(2); const float* const convw = in_ptr(10);
    float c3[3][8];
#pragma unroll
    for (int part = 0; part < 3; ++part) {
        float acc[8];
#pragma unroll
        for (int e = 0; e < 8; ++e) acc[e] = 0.f;
        if (i < L) {
#pragma unroll
            for (int tap = 0; tap < 4; ++tap) {
                float xin[8]; unpack8(*(const LAS u32x4*)(lds + 107008 + (part * 67 + i + tap) * 144 + cg * 16), xin);
                const LAS float* wp = (const LAS float*)(lds + 135952) + tap * 192 + part * 64 + cg * 8; const f32x4 w0 = *(const LAS f32x4*)wp, w1 = *(const LAS f32x4*)(wp + 4);
#pragma unroll
                for (int e = 0; e < 4; ++e) { acc[e] += xin[e] * w0[e]; acc[4 + e] += xin[4 + e] * w1[e]; }
            }
        }
#pragma unroll
        for (int e = 0; e < 8; ++e) c3[part][e] = acc[e] / (1.f + __expf(-acc[e]));
    }
    {
        float sq = 0.f, sk = 0.f;
#pragma unroll
        for (int e = 0; e < 8; ++e) { sq += c3[0][e] * c3[0][e]; sk += c3[1][e] * c3[1][e]; }
        sq = sum8(sq); sk = sum8(sk);
        const float rq = rsqrtf(sq + EPS) * 0.125f, rk = rsqrtf(sk + EPS);
#pragma unroll
        for (int e = 0; e < 8; ++e) { c3[0][e] *= rq; c3[1][e] *= rk; }
        *(LAS u32x4*)(sQ + i * 72 + cg * 8) = pack8f(c3[0]); *(LAS u32x4*)(sK + i * 72 + cg * 8) = pack8f(c3[1]);
    }
    if (wave == 0) {
        float g = 0.f, be = 0.f;
        if (lane < L) { const float al = AB[(size_t)(row0 + lane) * 16 + h], br = AB[(size_t)(row0 + lane) * 16 + 8 + h]; const float xx = al + in_ptr(12)[h];
            const float sp = fmaxf(xx, 0.f) + log1pf(expf(-fabsf(xx))); g = -expf(in_ptr(11)[h]) * sp; be = 1.f / (1.f + expf(-br)); }
        float c = g;
#pragma unroll
        for (int o = 1; o < 64; o <<= 1) { const float t = __shfl_up(c, o); if (lane >= o) c += t; }
        sG[lane] = c; sG[64 + lane] = be;
    }
    __syncthreads();
    DnIn nxt;
    if (next_item < NITEM) dn_fetch(next_item, tid, PROJ, cconv, convw, nxt);
    {
        const int mat = wave >> 2, mt = wave & 3, r16 = lane & 15, g4 = lane >> 4;
        const LAS bf16_t* X = mat ? sQ : sK; bf16x8 af[2];
#pragma unroll
        for (int ks = 0; ks < 2; ++ks) af[ks] = *(const LAS bf16x8*)(X + (16 * mt + r16) * 72 + 32 * ks + 8 * g4);
#pragma unroll
        for (int nt = 0; nt < 4; ++nt) {
            f32x4 acc = {0.f, 0.f, 0.f, 0.f};
#pragma unroll
            for (int ks = 0; ks < 2; ++ks) acc = mfma16(af[ks], *(const LAS bf16x8*)(sK + (16 * nt + r16) * 72 + 32 * ks + 8 * g4), acc);
            const int j = 16 * nt + r16; const float gj = sG[j];
#pragma unroll
            for (int r = 0; r < 4; ++r) { const int ii = 16 * mt + 4 * g4 + r; const float dec = __expf(sG[ii] - gj);
                if (mat == 0) sA[ii * 68 + (j & 3) * 16 + (j >> 2)] = (ii > j) ? sG[64 + ii] * acc[r] * dec : 0.f;
                else sO[3 * 4608 + ii * 72 + j] = (bf16_t)(pk((ii >= j) ? acc[r] * dec : 0.f, 0.f) & 0xffffu); }
        }
    }
    {
        const float gi = sG[i], bi = sG[64 + i], gl = sG[63]; const float egi = __expf(gi), ekl = __expf(gl - gi);
        float t[8];
#pragma unroll
        for (int e = 0; e < 8; ++e) { sR[i * 132 + cg * 8 + e] = c3[2][e] * bi; sR[i * 132 + 64 + cg * 8 + e] = c3[1][e] * bi * egi; t[e] = c3[0][e] * egi; }
        *(u32x4*)(dn + 2 * 8192 + i * 128 + cg * 16) = pack8f(t);
#pragma unroll
        for (int e = 0; e < 8; ++e) sO[2 * 4608 + (cg * 8 + e) * 72 + i] = (bf16_t)(pk(c3[1][e] * ekl, 0.f) & 0xffffu);
        if (tid == 0) ((float*)(ws + WS_GL))[item] = gl;
    }
    __syncthreads();
    {
        const int c = tid >> 2, p = tid & 3;
        float x[16];
#pragma unroll
        for (int jj = 0; jj < 16; ++jj) x[jj] = 0.f;
        if (!(flags & 1))
#pragma unroll
        for (int r = 0; r < 4; ++r) {
            float sd[16], rh[16];
#pragma unroll
            for (int t = 0; t < 16; ++t) { const int ii = 16 * r + t; float s = 0.f; rh[t] = sR[ii * 132 + c];
#pragma unroll
                for (int jj = 0; jj < 4 * r; ++jj) s += sA[ii * 68 + p * 16 + jj] * x[jj];
                sd[t] = s; }
#pragma unroll
            for (int t = 0; t < 16; ++t) { const int ii = 16 * r + t; float s = sd[t];
#pragma unroll
                for (int jj = 4 * r; jj <= (ii >> 2); ++jj) s += sA[ii * 68 + p * 16 + jj] * x[jj];
                s += quad_xor1(s); s += quad_xor2(s);
                const float xi = rh[t] - s, own = (p == (ii & 3)) ? 1.f : 0.f;
                x[ii >> 2] = fmaf(own, xi - x[ii >> 2], x[ii >> 2]); }
        }
        if (c < 64) {
#pragma unroll
            for (int jj = 0; jj < 16; ++jj) sO[0 * 4608 + c * 72 + 4 * jj + p] = (bf16_t)(pk(x[jj], 0.f) & 0xffffu);
        } else {
#pragma unroll
            for (int jj = 0; jj < 16; ++jj) sO[1 * 4608 + (4 * jj + p) * 72 + (c - 64)] = (bf16_t)(pk(x[jj], 0.f) & 0xffffu);
        }
    }
    __syncthreads();
    {
        const int row = tid >> 3, pc = tid & 7;
        *(u32x4*)(dn + 0 * 8192 + row * 128 + pc * 16) = *(const LAS u32x4*)((LAS unsigned char*)sO + 0 * 9216 + row * 144 + pc * 16);
        *(u32x4*)(dn + 1 * 8192 + row * 128 + pc * 16) = *(const LAS u32x4*)((LAS unsigned char*)sO + 1 * 9216 + row * 144 + pc * 16);
        *(u32x4*)(dn + 3 * 8192 + row * 128 + pc * 16) = *(const LAS u32x4*)((LAS unsigned char*)sO + 2 * 9216 + row * 144 + pc * 16);
        *(u32x4*)(dn + 4 * 8192 + row * 128 + pc * 16) = *(const LAS u32x4*)((LAS unsigned char*)sO + 3 * 9216 + row * 144 + pc * 16);
    }
    if (next_item < NITEM) dn_stage(tid, lds, nxt);
    __syncthreads();
}
DI void phase2_rows(const Args& a, const int wv) {
    int tid_ = wv * 64 + mk_lane_id(); asm volatile("" : "+v"(tid_)); const int tid = tid_, lane = tid & 63, wave = tid >> 6;
    const int gw = blockIdx.x * 8 + wave, NGW = gridDim.x * 8;
    unsigned char* ws = ws_ptr();
    const bf16_t* PROJ = (const bf16_t*)(ws + WS_PROJ); bf16_t* QN = (bf16_t*)(ws + WS_QN); bf16_t* KN = (bf16_t*)(ws + WS_KN);
    float gq[8], gk[8];
    { const f32x4 q0 = *(const f32x4*)(in_ptr(14) + (lane & 7) * 8), q1 = *(const f32x4*)(in_ptr(14) + (lane & 7) * 8 + 4), k0 = *(const f32x4*)(in_ptr(15) + (lane & 7) * 8), k1 = *(const f32x4*)(in_ptr(15) + (lane & 7) * 8 + 4);
#pragma unroll
      for (int e = 0; e < 4; ++e) { gq[e] = q0[e]; gq[4 + e] = q1[e]; gk[e] = k0[e]; gk[4 + e] = k1[e]; } }
    for (int rb = gw; rb < NT; rb += 4 * NGW) {
        u32x4 wq[4], wk[4];
#pragma unroll
        for (int t = 0; t < 4; ++t) { const int r = rb + t * NGW; if (r < NT) { const bf16_t* pr = PROJ + (size_t)r * NPROJ + lane * 8;
            wq[t] = *(const u32x4*)(pr + C_SBQ); wk[t] = *(const u32x4*)(pr + C_SBK); } }
#pragma unroll
        for (int t = 0; t < 4; ++t) { const int r = rb + t * NGW; if (r < NT) {
            float q[8], k[8];
            unpack8(wq[t], q); unpack8(wk[t], k);
            float sq = 0.f, sk = 0.f;
#pragma unroll
            for (int e = 0; e < 8; ++e) { sq += q[e] * q[e]; sk += k[e] * k[e]; }
            const float rq = rsqrtf(sum8(sq) * (1.f / 64.f) + EPS), rk = rsqrtf(sum8(sk) * (1.f / 64.f) + EPS);
#pragma unroll
            for (int e = 0; e < 8; ++e) { q[e] = q[e] * rq * gq[e]; k[e] = k[e] * rk * gk[e]; }
            *(u32x4*)(QN + (size_t)r * 512 + lane * 8) = pack8f(q); *(u32x4*)(KN + (size_t)r * 512 + lane * 8) = pack8f(k);
        } }
    }
}
DI void p3_outputs(const int wv, const int bidx, const int nblk) {
    int tid_ = wv * 64 + mk_lane_id(); asm volatile("" : "+v"(tid_)); const int tid = tid_, lane = tid & 63, wave = tid >> 6;
    const int gw = bidx * 8 + wave, NGW = nblk * 8;
    unsigned char* ws = ws_ptr();
    const bf16_t* PROJ = (const bf16_t*)(ws + WS_PROJ); const bf16_t* KN = (const bf16_t*)(ws + WS_KN);
    float* const outp = out_ptr();
    for (int rb = gw; rb < NT; rb += 4 * NGW) {
        u32x4 wk[4], wvv[4];
#pragma unroll
        for (int t = 0; t < 4; ++t) { const int r = rb + t * NGW; if (r < NT) { wk[t] = *(const u32x4*)(KN + (size_t)r * 512 + lane * 8); wvv[t] = *(const u32x4*)(PROJ + (size_t)r * NPROJ + C_SBV + lane * 8); } }
#pragma unroll
        for (int t = 0; t < 4; ++t) { const int r = rb + t * NGW; if (r < NT) {
            float k[8], v[8]; unpack8(wk[t], k); unpack8(wvv[t], v);
            float* ko = outp + (r < NP ? O_KP + (size_t)r * 512 : O_KS + (size_t)(r - NP) * 512) + lane * 8;
            float* vo = outp + (r < NP ? O_VP + (size_t)r * 512 : O_VS + (size_t)(r - NP) * 512) + lane * 8;
            __builtin_nontemporal_store((f32x4){k[0], k[1], k[2], k[3]}, (f32x4*)ko); __builtin_nontemporal_store((f32x4){k[4], k[5], k[6], k[7]}, (f32x4*)(ko + 4));
            __builtin_nontemporal_store((f32x4){v[0], v[1], v[2], v[3]}, (f32x4*)vo); __builtin_nontemporal_store((f32x4){v[4], v[5], v[6], v[7]}, (f32x4*)(vo + 4));
        } }
    }
    for (int idx = bidx * 512 + tid; idx < 40 * 3 * 192; idx += nblk * 512) {
        const int seq = idx / 576, rem = idx - seq * 576, j = rem / 192, cgp = rem - j * 192;
        const int row = seq < 8 ? seq * 2048 + 2045 + j : NP + (seq - 8) * 32 + 29 + j;
        float f[8]; unpack8(*(const u32x4*)(PROJ + (size_t)row * NPROJ + cgp * 8), f);
        float* o = outp + (seq < 8 ? O_CONVP + (size_t)(seq * 3 + j) * 1536 : O_CONVS + (size_t)((seq - 8) * 3 + j) * 1536) + cgp * 8;
        *(f32x4*)o = (f32x4){f[0], f[1], f[2], f[3]}; *(f32x4*)(o + 4) = (f32x4){f[4], f[5], f[6], f[7]};
    }
}
DI void dn_scan_chain(const Args& a, LAS unsigned char* lds, int chain, const int wv) {
    int tid_ = wv * 64 + mk_lane_id(); asm volatile("" : "+v"(tid_)); const int tid = tid_, lane = tid & 63, wave = tid >> 6, r16 = lane & 15, g4 = lane >> 4, s = wave & 3, hh = wave >> 2;
    unsigned char* ws = ws_ptr();
    int b, h, nch, item0, row0, L; bool samp;
    if (chain < 64) { b = chain >> 3; h = chain & 7; nch = 32; item0 = chain * 32; row0 = b * 2048; L = 64; samp = false; }
    else { const int sid = chain - 64; b = sid >> 3; h = sid & 7; nch = 1; item0 = 2048 + sid; row0 = NP + b * 32; L = 32; samp = true; }
    LAS unsigned char* buf0 = lds;
    LAS unsigned char* sST = lds + 92160;
    LAS unsigned char* sVn = lds + 110592;
    LAS float* sOo = (LAS float*)(lds + 119808);
    const unsigned char* dn = ws + WS_DN + (size_t)item0 * 40960;
    const float* GL = (const float*)(ws + WS_GL) + item0;
    const bf16_t* PROJ = (const bf16_t*)(ws + WS_PROJ); bf16_t* OA = (bf16_t*)(ws + WS_OA);
    const int prow = tid >> 3, ppc = tid & 7;
    float S[2][4]; const float* const sd0 = in_ptr(3);
    float* dout = out_ptr() + (samp ? O_DELTAS : O_DELTAP) + (size_t)(b * 8 + h) * 4096;
#pragma unroll
    for (int mt = 0; mt < 2; ++mt)
#pragma unroll
        for (int r = 0; r < 4; ++r) S[mt][r] = samp ? sd0[(size_t)(b * 8 + h) * 4096 + (32 * hh + 16 * mt + 4 * g4 + r) * 64 + 16 * s + r16] : 0.f;
    u32x4 pre[5];
    {
#pragma unroll
        for (int t = 0; t < 5; ++t) pre[t] = *(const u32x4*)(dn + t * 8192 + prow * 128 + ppc * 16);
#pragma unroll
        for (int t = 0; t < 5; ++t) *(LAS u32x4*)(buf0 + t * 9216 + prow * 144 + ppc * 16) = pre[t];
        if (nch > 1) {
#pragma unroll
            for (int t = 0; t < 5; ++t) pre[t] = *(const u32x4*)(dn + (size_t)40960 + t * 8192 + prow * 128 + ppc * 16);
        }
#pragma unroll
        for (int mt = 0; mt < 2; ++mt) { u32x2 w; w.x = pk(S[mt][0], S[mt][1]); w.y = pk(S[mt][2], S[mt][3]); *(LAS u32x2*)(sST + (16 * s + r16) * 144 + (32 * hh + 16 * mt + 4 * g4) * 2) = w; }
    }
    float gout[8];
    { const f32x4 g0 = *(const f32x4*)(in_ptr(13) + ppc * 8), g1 = *(const f32x4*)(in_ptr(13) + ppc * 8 + 4);
#pragma unroll
      for (int e = 0; e < 4; ++e) { gout[e] = g0[e]; gout[4 + e] = g1[e]; } }
    u32x4 zw_n = {0u, 0u, 0u, 0u};
    if (prow < L) zw_n = *(const u32x4*)(PROJ + (size_t)(row0 + prow) * NPROJ + C_Z + h * 64 + ppc * 8);
    float gl_n = GL[0];
    __syncthreads();
    for (int n = 0; n < nch; ++n) {
        const int cur = n & 1;
        LAS unsigned char* STc = sST + cur * 9216; LAS unsigned char* STn = sST + (cur ^ 1) * 9216;
        LAS unsigned char* buf = buf0 + cur * 46080;
        if (n + 1 < nch) {
#pragma unroll
            for (int t = 0; t < 5; ++t) *(LAS u32x4*)(buf0 + (cur ^ 1) * 46080 + t * 9216 + prow * 144 + ppc * 16) = pre[t];
        }
        const u32x4 zw = zw_n; const float eg = __expf(gl_n);
        if (n + 1 < nch) {
            if (prow < L) zw_n = *(const u32x4*)(PROJ + (size_t)(row0 + 64 * (n + 1) + prow) * NPROJ + C_Z + h * 64 + ppc * 8);
            gl_n = GL[n + 1];
        }
        if (n + 2 < nch) {
#pragma unroll
            for (int t = 0; t < 5; ++t) pre[t] = *(const u32x4*)(dn + (size_t)(n + 2) * 40960 + t * 8192 + prow * 128 + ppc * 16);
        }
        bf16x8 bs[2];
#pragma unroll
        for (int ks = 0; ks < 2; ++ks) bs[ks] = *(const LAS bf16x8*)(STc + (16 * s + r16) * 144 + (32 * ks + 8 * g4) * 2);
#pragma unroll
        for (int mt = 0; mt < 2; ++mt) {
            const int i0 = 32 * hh + 16 * mt; f32x4 acc = {0.f, 0.f, 0.f, 0.f};
#pragma unroll
            for (int ks = 0; ks < 2; ++ks) acc = mfma16(*(const LAS bf16x8*)(buf + 1 * 9216 + (i0 + r16) * 144 + (32 * ks + 8 * g4) * 2), bs[ks], acc);
            const u32x2 uw = *(const LAS u32x2*)(buf + 0 * 9216 + (16 * s + r16) * 144 + (i0 + 4 * g4) * 2);
            const float v0 = __uint_as_float(uw.x << 16) - acc[0], v1 = __uint_as_float(uw.x & 0xffff0000u) - acc[1], v2 = __uint_as_float(uw.y << 16) - acc[2], v3 = __uint_as_float(uw.y & 0xffff0000u) - acc[3];
            u32x2 w; w.x = pk(v0, v1); w.y = pk(v2, v3); *(LAS u32x2*)(sVn + (16 * s + r16) * 144 + (i0 + 4 * g4) * 2) = w;
        }
        __syncthreads();
        bf16x8 bv[2];
#pragma unroll
        for (int ks = 0; ks < 2; ++ks) bv[ks] = *(const LAS bf16x8*)(sVn + (16 * s + r16) * 144 + (32 * ks + 8 * g4) * 2);
#pragma unroll
        for (int mt = 0; mt < 2; ++mt) {
            const int i0 = 32 * hh + 16 * mt; f32x4 acc = {0.f, 0.f, 0.f, 0.f};
#pragma unroll
            for (int ks = 0; ks < 2; ++ks) acc = mfma16(*(const LAS bf16x8*)(buf + 2 * 9216 + (i0 + r16) * 144 + (32 * ks + 8 * g4) * 2), bs[ks], acc);
#pragma unroll
            for (int ks = 0; ks < 2; ++ks) acc = mfma16(*(const LAS bf16x8*)(buf + 4 * 9216 + (i0 + r16) * 144 + (32 * ks + 8 * g4) * 2), bv[ks], acc);
#pragma unroll
            for (int r = 0; r < 4; ++r) sOo[(i0 + 4 * g4 + r) * 65 + 16 * s + r16] = acc[r];
        }
#pragma unroll
        for (int mt = 0; mt < 2; ++mt) {
            const int a0 = 32 * hh + 16 * mt; f32x4 acc = {S[mt][0] * eg, S[mt][1] * eg, S[mt][2] * eg, S[mt][3] * eg};
#pragma unroll
            for (int ks = 0; ks < 2; ++ks) acc = mfma16(*(const LAS bf16x8*)(buf + 3 * 9216 + (a0 + r16) * 144 + (32 * ks + 8 * g4) * 2), bv[ks], acc);
#pragma unroll
            for (int r = 0; r < 4; ++r) S[mt][r] = acc[r];
            u32x2 w; w.x = pk(acc[0], acc[1]); w.y = pk(acc[2], acc[3]); *(LAS u32x2*)(STn + (16 * s + r16) * 144 + (a0 + 4 * g4) * 2) = w;
        }
        __syncthreads();
        {
            float o[8], z[8], ss = 0.f;
#pragma unroll
            for (int e = 0; e < 8; ++e) { o[e] = sOo[prow * 65 + ppc * 8 + e]; ss += o[e] * o[e]; }
            const float rs = rsqrtf(sum8(ss) * (1.f / 64.f) + EPS);
            unpack8(zw, z);
#pragma unroll
            for (int e = 0; e < 8; ++e) o[e] = o[e] * rs * gout[e] * (z[e] / (1.f + __expf(-z[e])));
            if (prow < L) *(u32x4*)(OA + (size_t)(row0 + 64 * n + prow) * DM + h * 64 + ppc * 8) = pack8f(o);
        }
    }
    __syncthreads();
#pragma unroll
    for (int mt = 0; mt < 2; ++mt)
#pragma unroll
        for (int r = 0; r < 4; ++r) dout[(32 * hh + 16 * mt + 4 * g4 + r) * 64 + 16 * s + r16] = S[mt][r];
}
DI void attn_item(const Args& a, LAS unsigned char* lds, int it, const int wv) {
    int tid_ = wv * 64 + mk_lane_id(); asm volatile("" : "+v"(tid_)); const int tid = tid_, lane = tid & 63, wave = tid >> 6, r16 = lane & 15, g4 = lane >> 4;
    unsigned char* ws = ws_ptr();
    const bf16_t* PROJ = (const bf16_t*)(ws + WS_PROJ); const bf16_t* QN = (const bf16_t*)(ws + WS_QN); const bf16_t* KN = (const bf16_t*)(ws + WS_KN); bf16_t* OA = (bf16_t*)(ws + WS_OA);
    int b, h, rowbase, nq, qpos0, kb_top; bool samp;
    if (it < 1024) { const int bh = it >> 4, qt = it & 15; b = bh >> 3; h = bh & 7; rowbase = b * 2048 + qt * 128; nq = 128; qpos0 = qt * 128; kb_top = (qpos0 >> 6) + 1; samp = false; }
    else { const int sid = it - 1024; b = sid >> 3; h = sid & 7; rowbase = NP + b * 32; nq = 32; qpos0 = 4096; kb_top = 64; samp = true; }
    LAS bf16_t* sKt = (LAS bf16_t*)(lds);
    LAS bf16_t* sVt = (LAS bf16_t*)(lds + 9216);
    LAS float* sRm = (LAS float*)(lds + 18432);
    const int qi = 16 * wave + r16; const bool wvalid = (16 * wave < nq);
    const int qrow = rowbase + (wvalid ? qi : 0), qpos = qpos0 + qi;
    bf16x8 qf[2];
#pragma unroll
    for (int ks = 0; ks < 2; ++ks) qf[ks] = *(const bf16x8*)(QN + (size_t)qrow * 512 + h * 64 + 32 * ks + 8 * g4);
    f32x4 o[4];
#pragma unroll
    for (int nt = 0; nt < 4; ++nt) o[nt] = (f32x4){0.f, 0.f, 0.f, 0.f};
    float R = 0.f; bool wdone = !wvalid;
    const int key = tid >> 3, cg = tid & 7;
    const float* const cK = in_ptr(4); const float* const cV = in_ptr(5);
#define ATT_LOADKV(KB) do { const int kp = 64 * (KB) + key; kw = (u32x4){0u, 0u, 0u, 0u}; vw = (u32x4){0u, 0u, 0u, 0u}; \
        if (!samp || kp >= 4096) { const int j = samp ? kp - 4096 : kp; \
            if (!samp || j < 32) { const int krow = samp ? NP + b * 32 + j : b * 2048 + j; \
                kw = *(const u32x4*)(KN + (size_t)krow * 512 + h * 64 + cg * 8); vw = *(const u32x4*)(PROJ + (size_t)krow * NPROJ + C_SBV + h * 64 + cg * 8); } \
        } else { const size_t off = ((size_t)(b * 4096 + kp) * 8 + h) * 64 + cg * 8; \
            const f32x4 k0 = *(const f32x4*)(cK + off), k1 = *(const f32x4*)(cK + off + 4), v0 = *(const f32x4*)(cV + off), v1 = *(const f32x4*)(cV + off + 4); \
            kw = pg8::pack8(k0, k1); vw = pg8::pack8(v0, v1); } } while (0)
    u32x4 kw, vw;
    ATT_LOADKV(kb_top);
    for (int kb = kb_top; kb >= 0; --kb) {
        {
            *(LAS u32x4*)(sKt + key * 72 + cg * 8) = kw;
            sVt[(cg * 8 + 0) * 72 + key] = (bf16_t)(vw.x & 0xffffu); sVt[(cg * 8 + 1) * 72 + key] = (bf16_t)(vw.x >> 16);
            sVt[(cg * 8 + 2) * 72 + key] = (bf16_t)(vw.y & 0xffffu); sVt[(cg * 8 + 3) * 72 + key] = (bf16_t)(vw.y >> 16);
            sVt[(cg * 8 + 4) * 72 + key] = (bf16_t)(vw.z & 0xffffu); sVt[(cg * 8 + 5) * 72 + key] = (bf16_t)(vw.z >> 16);
            sVt[(cg * 8 + 6) * 72 + key] = (bf16_t)(vw.w & 0xffffu); sVt[(cg * 8 + 7) * 72 + key] = (bf16_t)(vw.w >> 16);
        }
        if (kb > 0) ATT_LOADKV(kb - 1);
        __syncthreads();
        const bool wact = !wdone && (64 * kb < qpos0 + 16 * wave + 15);
        if (wact) {
            float zz[4][4], sp[4][4], tl[4], tot[4], aft[4];
#pragma unroll
            for (int mt = 0; mt < 4; ++mt) {
                f32x4 acc = {0.f, 0.f, 0.f, 0.f};
#pragma unroll
                for (int ks = 0; ks < 2; ++ks) acc = mfma16(*(const LAS bf16x8*)(sKt + (16 * mt + r16) * 72 + 32 * ks + 8 * g4), qf[ks], acc);
                tl[mt] = 0.f;
#pragma unroll
                for (int r = 0; r < 4; ++r) { const float z = acc[r] * 0.125f; const bool valid = (64 * kb + 16 * mt + 4 * g4 + r) < qpos;
                    zz[mt][r] = z; sp[mt][r] = valid ? fmaxf(z, 0.f) + __logf(1.f + __expf(-fabsf(z))) : 0.f; tl[mt] += sp[mt][r]; }
                const float v1 = __shfl_xor(tl[mt], 16), v2 = __shfl_xor(tl[mt], 32), v3 = __shfl_xor(tl[mt], 48);
                tot[mt] = tl[mt] + v1 + v2 + v3;
                aft[mt] = ((g4 ^ 1) > g4 ? v1 : 0.f) + ((g4 ^ 2) > g4 ? v2 : 0.f) + ((g4 ^ 3) > g4 ? v3 : 0.f);
            }
            float pa[4][4];
            float later = 0.f;
#pragma unroll
            for (int mt = 3; mt >= 0; --mt) {
                float c = R + later + aft[mt];
#pragma unroll
                for (int r = 3; r >= 0; --r) { c += sp[mt][r]; const bool valid = (64 * kb + 16 * mt + 4 * g4 + r) < qpos; pa[mt][r] = valid ? __expf(zz[mt][r] - c) : 0.f; }
                later += tot[mt];
            }
            R += later;
            bf16x8 pf[2];
#pragma unroll
            for (int ks = 0; ks < 2; ++ks) { u32x4 w; w.x = pk(pa[2 * ks][0], pa[2 * ks][1]); w.y = pk(pa[2 * ks][2], pa[2 * ks][3]); w.z = pk(pa[2 * ks + 1][0], pa[2 * ks + 1][1]); w.w = pk(pa[2 * ks + 1][2], pa[2 * ks + 1][3]);
                pf[ks] = __builtin_bit_cast(bf16x8, w); }
#pragma unroll
            for (int nt = 0; nt < 4; ++nt)
#pragma unroll
                for (int ks = 0; ks < 2; ++ks) {
                    const s16x4 lo = *(const LAS s16x4*)(sVt + (16 * nt + r16) * 72 + 32 * ks + 4 * g4), hi = *(const LAS s16x4*)(sVt + (16 * nt + r16) * 72 + 32 * ks + 16 + 4 * g4);
                    o[nt] = mfma16(pf[ks], __builtin_shufflevector(lo, hi, 0, 1, 2, 3, 4, 5, 6, 7), o[nt]);
                }
        }
        {
            float rm = R;
            rm = fminf(rm, __shfl_xor(rm, 1)); rm = fminf(rm, __shfl_xor(rm, 2)); rm = fminf(rm, __shfl_xor(rm, 4)); rm = fminf(rm, __shfl_xor(rm, 8)); rm = fminf(rm, __shfl_xor(rm, 16)); rm = fminf(rm, __shfl_xor(rm, 32));
            if (!wvalid) rm = 1e30f;
            if (rm > SB_THRESH) wdone = true;
            if (lane == 0) sRm[wave] = rm;
        }
        __syncthreads();
        float m = sRm[0];
#pragma unroll
        for (int w = 1; w < 8; ++w) m = fminf(m, sRm[w]);
        if (m > SB_THRESH) break;
    }
#undef ATT_LOADKV
    if (wvalid) {
#pragma unroll
        for (int nt = 0; nt < 4; ++nt)
#pragma unroll
            for (int r = 0; r < 4; ++r) OA[(size_t)(rowbase + 16 * wave + 4 * g4 + r) * DM + 512 + h * 64 + 16 * nt + r16] = (bf16_t)(pk(o[nt][r], 0.f) & 0xffffu);
    }
    __syncthreads();
}
DI void tail_reduce(int mode, int S, const int wv) {
    int tid_ = wv * 64 + mk_lane_id(); asm volatile("" : "+v"(tid_)); const int tid = tid_, lane = tid & 63, wave = tid >> 6;
    const int gw = blockIdx.x * 8 + wave, NGW = gridDim.x * 8;
    unsigned char* ws = ws_ptr();
    const bf16_t* PART = (const bf16_t*)(ws + WS_PART); bf16_t* HB = (bf16_t*)(ws + WS_HB);
    for (int it = gw; it < 2048; it += NGW) {
        const int rl = it >> 1, jb = 2 * (it & 1), row = NP + rl;
        f32x4 acc[2];
#pragma unroll
        for (int j = 0; j < 2; ++j) acc[j] = (f32x4){0.f, 0.f, 0.f, 0.f};
#pragma unroll
        for (int s = 0; s < S; ++s) {
            const u32x2* p = (const u32x2*)(PART + (size_t)s * 1048576 + (size_t)rl * 1024);
#pragma unroll
            for (int j = 0; j < 2; ++j) { const u32x2 w = p[lane + 64 * (jb + j)]; acc[j] += (f32x4){__uint_as_float(w.x << 16), __uint_as_float(w.x & 0xffff0000u), __uint_as_float(w.y << 16), __uint_as_float(w.y & 0xffff0000u)}; }
        }
        if (mode == 7) {
            const float rs = pg8::row_rs((const float*)(ws + WS_SS2), row);
            const bf16_t* PP = (const bf16_t*)(ws + WS_PP) + (size_t)row * DM; float* y = out_ptr() + O_Y + (size_t)row * DM;
#pragma unroll
            for (int j = 0; j < 2; ++j) { const u32x2 hw = ((const u32x2*)(HB + (size_t)row * DM))[lane + 64 * (jb + j)]; const u32x2 pw = ((const u32x2*)PP)[lane + 64 * (jb + j)];
                const f32x4 h = {__uint_as_float(hw.x << 16), __uint_as_float(hw.x & 0xffff0000u), __uint_as_float(hw.y << 16), __uint_as_float(hw.y & 0xffff0000u)};
                const f32x4 pp = {__uint_as_float(pw.x << 16), __uint_as_float(pw.x & 0xffff0000u), __uint_as_float(pw.y << 16), __uint_as_float(pw.y & 0xffff0000u)};
                const f32x4 t = acc[j] * (-rs);
                const f32x4 e = {__expf(t[0]), __expf(t[1]), __expf(t[2]), __expf(t[3])};
                ((f32x4*)y)[lane + 64 * (jb + j)] = h + pp / (e + 1.f); }
        } else {
            const float* xs = in_ptr(1) + (size_t)rl * DM; float ss = 0.f;
#pragma unroll
            for (int j = 0; j < 2; ++j) { f32x4 base;
                if (mode == 4) base = ((const f32x4*)xs)[lane + 64 * (jb + j)];
                else { const u32x2 hw = ((const u32x2*)(HB + (size_t)row * DM))[lane + 64 * (jb + j)]; base = (f32x4){__uint_as_float(hw.x << 16), __uint_as_float(hw.x & 0xffff0000u), __uint_as_float(hw.y << 16), __uint_as_float(hw.y & 0xffff0000u)}; }
                const f32x4 v = acc[j] + base; ss += pg8::dot4(v);
                u32x2 o; o.x = pk(v[0], v[1]); o.y = pk(v[2], v[3]); ((u32x2*)(HB + (size_t)row * DM))[lane + 64 * (jb + j)] = o; }
            ss = wave_sum(ss);
            float* SS = (float*)(ws + (mode == 4 ? WS_SS1 : WS_SS2));
            if (lane < 8) SS[(size_t)row * 16 + 4 * jb + lane] = (lane == 0) ? ss : 0.f;
        }
    }
}
#ifndef PROBE_FLAGS
#define PROBE_FLAGS 0
#endif
#ifndef PROBE_REPEAT
#define PROBE_REPEAT -1
#endif
#ifndef MK_SPLIT
#define MK_SPLIT 0
#endif
__global__ void __launch_bounds__(512, 2) hybrid_fwd(Args a) {
    extern __shared__ __attribute__((aligned(16))) unsigned char lds_raw[];
    LAS unsigned char* lds = (LAS unsigned char*)lds_raw;
    cg::grid_group grid = cg::this_grid();
    const int lo = a.ph_lo, hi = a.ph_hi;
    volatile LAS unsigned* MISC = (volatile LAS unsigned*)(lds + MISC_OFF);
    const int wv = __builtin_amdgcn_readfirstlane((int)threadIdx.x >> 6);
    if (threadIdx.x < 2) MISC[threadIdx.x] = 0u;
    __syncthreads();
    const int bar_off = a.li * 16384;
    (void)xcd_barrier_post((unsigned*)(ws_ptr() + WS_CTL + bar_off), MISC, wv);
    if (lo < 0) grid.sync();
    const int G = gridDim.x, c = blockIdx.x;
    typedef pg8::bf16_t pb;
#define IN(k) (lo <= (k) && (k) < hi)
#define SEAM_NOW() do { XcdBarrier xb_; xb_.bar = (unsigned*)(ws_ptr() + WS_CTL + bar_off); xb_.x = xb_xcc_id(); xb_.st = MISC; xb_.wv = wv; xcd_barrier(xb_); } while (0)
#define SEAM(k) do { if (IN(k) && IN((k) + 1)) { XcdBarrier xb_; xb_.bar = (unsigned*)(ws_ptr() + WS_CTL + bar_off); xb_.x = xb_xcc_id(); xb_.st = MISC; xb_.wv = wv; xcd_barrier(xb_); } } while (0)
    if (IN(0)) phase0(a, lds, wv);
    SEAM(0);
    if (IN(1)) {
        unsigned char* const ws = ws_ptr(); (void)ws;
        { pg8::Gemm g{(const pb*)(ws + WS_U), (const pb*)(ws + WS_WIN), NT, NPROJ, DM, DM}; pg8::StaticOrder S; S.init(NT, NPROJ, G, c);
          pg8::EpiProj E{(pb*)(ws + WS_PROJ), (float*)(ws + WS_AB)};
          pg8::gemm_phase<pg8::EpiProj, pg8::StaticOrder, true, true, 1024, 1024>(lds, g, S, E, wv); }
    }
    SEAM(1);
    if (IN(2)) {
        unsigned char* const ws = ws_ptr(); (void)ws;
        const int flags = (lo == 0) ? a.pad : 0;
        if (!(flags & 4)) {
            if (c < NITEM) { int t_ = wv * 64 + mk_lane_id(); asm volatile("" : "+v"(t_)); DnIn d0; dn_fetch(c, t_, (const bf16_t*)(ws + WS_PROJ), in_ptr(2), in_ptr(10), d0); dn_stage(t_, lds, d0); }
            __syncthreads();
            for (int it = c; it < NITEM; it += G) dn_prep_item(a, lds, it, it + G, flags, wv);
        }
        if (!(flags & 2)) phase2_rows(a, wv);
    }
    SEAM(2);
    if (IN(3)) {
        unsigned char* const ws = ws_ptr(); (void)ws;
        if (G >= 128) {
            if (c < 64) dn_scan_chain(a, lds, c, wv);
            else { for (int ch = c; ch < 320; ch += G - 64) dn_scan_chain(a, lds, ch, wv);
                   for (int it = c - 64; it < 1280; it += G - 64) attn_item(a, lds, it, wv);
                 }
        } else {
            for (int w = c; w < 320 + 1280; w += G) { if (w < 320) dn_scan_chain(a, lds, w, wv); else attn_item(a, lds, w - 320, wv); }
        }
    }
    SEAM(3);
    if (IN(4)) {
        unsigned char* const ws = ws_ptr(); (void)ws;
        { pg8::Gemm g{(const pb*)(ws + WS_OA), (const pb*)(ws + WS_WOUT), NP, DM, DM, DM}; pg8::StaticOrder S; S.init(NP, DM, G, c);
          pg8::EpiRes<false> E{in_ptr(0), in_ptr(1), (pb*)(ws + WS_HB), (float*)(ws + WS_SS1)};
          pg8::gemm_phase<pg8::EpiRes<false>, pg8::StaticOrder, true, true, 1024, 1024>(lds, g, S, E, wv); }
        { pg8::Gemm g{(const pb*)(ws + WS_OA), (const pb*)(ws + WS_WOUT), NT, DM, 256, DM}; pg8::TailOrder T; T.init(4, G, c);
          pg8::EpiPart E{(pb*)(ws + WS_PART)};
          pg8::gemm_phase<pg8::EpiPart, pg8::TailOrder, true, true, 256, 1024>(lds, g, T, E, wv); }
        if (G >= 128) { if (c >= 64) {
          pg8::Gemm g{(const pb*)(ws + WS_PB), (const pb*)(ws + WS_WPJ), NT, DM, 256, 256}; pg8::StaticOrder S; S.init(NT, DM, G - 64, c - 64);
          pg8::EpiBf E{(pb*)(ws + WS_PP), DM};
          pg8::gemm_phase<pg8::EpiBf, pg8::StaticOrder, true, true, 256, 256>(lds, g, S, E, wv); } }
        else { pg8::Gemm g{(const pb*)(ws + WS_PB), (const pb*)(ws + WS_WPJ), NT, DM, 256, 256}; pg8::StaticOrder S; S.init(NT, DM, G, c);
          pg8::EpiBf E{(pb*)(ws + WS_PP), DM};
          pg8::gemm_phase<pg8::EpiBf, pg8::StaticOrder, true, true, 256, 256>(lds, g, S, E, wv); }
        SEAM_NOW(); tail_reduce(4, 4, wv);
    }
    SEAM(4);
    if (IN(5)) {
        unsigned char* const ws = ws_ptr(); (void)ws;
        pg8::Gemm g{(const pb*)(ws + WS_HB), (const pb*)(ws + WS_WUP), NT, FF, DM, DM}; pg8::StaticOrder S; S.init(NT, FF, G, c);
        pg8::EpiUp E{(const float*)(ws + WS_SS1), (pb*)(ws + WS_ACT)};
        pg8::gemm_phase<pg8::EpiUp, pg8::StaticOrder, true, true, 1024, 1024>(lds, g, S, E, wv);
    }
    SEAM(5);
    if (IN(6)) {
        unsigned char* const ws = ws_ptr(); (void)ws;
        { pg8::Gemm g{(const pb*)(ws + WS_ACT), (const pb*)(ws + WS_WDN), NP, DM, FF, FF}; pg8::StaticOrder S; S.init(NP, DM, G, c);
          pg8::EpiRes<true> E{nullptr, nullptr, (pb*)(ws + WS_HB), (float*)(ws + WS_SS2)};
          pg8::gemm_phase<pg8::EpiRes<true>, pg8::StaticOrder, true, true, 4096, 4096>(lds, g, S, E, wv); }
        { pg8::Gemm g{(const pb*)(ws + WS_ACT), (const pb*)(ws + WS_WDN), NT, DM, 256, FF}; pg8::TailOrder T; T.init(16, G, c);
          pg8::EpiPart E{(pb*)(ws + WS_PART)};
          pg8::gemm_phase<pg8::EpiPart, pg8::TailOrder, true, true, 256, 4096>(lds, g, T, E, wv); }
        SEAM_NOW(); tail_reduce(6, 16, wv);
    }
    SEAM(6);
    if (IN(7)) {
        unsigned char* const ws = ws_ptr(); (void)ws;
        { pg8::Gemm g{(const pb*)(ws + WS_HB), (const pb*)(ws + WS_WGT), NP, DM, DM, DM}; pg8::StaticOrder S; S.init(NP, DM, G, c);
          pg8::EpiOut E{(const float*)(ws + WS_SS2), (const pb*)(ws + WS_HB), (const pb*)(ws + WS_PP), out_ptr() + O_Y};
          pg8::gemm_phase<pg8::EpiOut, pg8::StaticOrder, true, true, 1024, 1024>(lds, g, S, E, wv); }
        { pg8::Gemm g{(const pb*)(ws + WS_HB), (const pb*)(ws + WS_WGT), NT, DM, 256, DM}; pg8::TailOrder T; T.init(4, G, c);
          pg8::EpiPart E{(pb*)(ws + WS_PART)};
          pg8::gemm_phase<pg8::EpiPart, pg8::TailOrder, true, true, 256, 1024>(lds, g, T, E, wv); }
        if (G >= 128) { if (c >= 64) p3_outputs(wv, c - 64, G - 64); } else p3_outputs(wv, c, G);
        SEAM_NOW(); tail_reduce(7, 4, wv);
    }
#undef IN
#undef SEAM
}

extern "C" void kernel_launch(void* const* d_in, const int* in_sizes, int n_in, void* d_out, int out_size, void* d_ws, size_t ws_size, hipStream_t stream) {
    static int grid = 0;
    if (grid == 0) {
        if (n_in != 23 || ws_size < WS_END) { fprintf(stderr, "kernel_launch: expected 23 inputs and >= %zu bytes of workspace (got %d, %zu)\n", (size_t)WS_END, n_in, ws_size); grid = -1; return; }
        int dev = 0, cus = 0, per_cu = 0;
        hipGetDevice(&dev); hipDeviceGetAttribute(&cus, hipDeviceAttributeMultiprocessorCount, dev);
        if (hipFuncSetAttribute((const void*)hybrid_fwd, hipFuncAttributeMaxDynamicSharedMemorySize, LDS_BYTES) != hipSuccess) { fprintf(stderr, "kernel_launch: hipFuncSetAttribute failed\n"); grid = -1; return; }
        if (hipOccupancyMaxActiveBlocksPerMultiprocessor(&per_cu, (const void*)hybrid_fwd, 512, LDS_BYTES) != hipSuccess || per_cu < 1) { fprintf(stderr, "kernel_launch: occupancy query says %d blocks per CU\n", per_cu); (void)hipGetLastError(); per_cu = 1; }
        grid = cus * 1;
        if (per_cu < 1) grid = -1;
    }
    if (grid < 0) return;
    if (hipMemsetAsync((char*)d_ws + WS_CTL, 0, CTL_BYTES, stream) != hipSuccess) { fprintf(stderr, "kernel_launch: hipMemsetAsync failed\n"); return; }
    Args a{};
    for (int i = 0; i < 23; ++i) a.in[i] = (const float*)d_in[i];
    a.out = (float*)d_out; a.ws = (unsigned char*)d_ws;
#if MK_SPLIT
    for (int k = 0; k < 8; ++k) { a.ph_lo = k; a.ph_hi = k + 1; hipLaunchKernelGGL(hybrid_fwd, dim3(grid), dim3(512), LDS_BYTES, stream, a); }
#else
#if PROBE_REPEAT >= 0
    for (int part = 0; part < 2; ++part) {
        a.ph_lo = part ? PROBE_REPEAT : 0; a.ph_hi = part ? 8 : PROBE_REPEAT + 1; a.li = part; a.pad = part ? 0 : PROBE_FLAGS;
        void* args[] = {&a};
        hipError_t e = hipLaunchCooperativeKernel((const void*)hybrid_fwd, dim3(grid), dim3(512), args, LDS_BYTES, stream);
        if (e != hipSuccess) fprintf(stderr, "cooperative launch failed: %s (grid %d)\n", hipGetErrorString(e), grid);
    }
#else
    a.ph_lo = 0; a.ph_hi = 8;
    void* args[] = {&a};
    hipError_t e = hipLaunchCooperativeKernel((const void*)hybrid_fwd, dim3(grid), dim3(512), args, LDS_BYTES, stream);
    if (e != hipSuccess) fprintf(stderr, "cooperative launch failed: %s (grid %d)\n", hipGetErrorString(e), grid);
#endif
#endif
}
```
